# Optimizing an MI355X kernel written in HIP

```python
import math
import jax, jax.numpy as jnp
from jax import lax
import numpy as np

D_MODEL = 2048
BATCH = 4
SEQ = 2048
DEPTH = 4

D_MIX = D_MODEL
ATTN_WIDTH = D_MIX // 2
ATTN_HEAD_DIM = 128
ATTN_HEADS = ATTN_WIDTH // ATTN_HEAD_DIM
ROPE_DIM = ATTN_HEAD_DIM // 4
ROPE_THETA = 500000.0
MOBA_BLOCK = 256
MOBA_TOPK = 3
Q_CHUNK = 16

SSD_WIDTH = D_MIX - ATTN_WIDTH
SSD_HEAD_DIM = 64
SSD_HEADS = SSD_WIDTH // SSD_HEAD_DIM
SSD_GROUPS = 2
SSD_STATE = 128
SSD_CONV = 4
SSD_CHUNK = 128
CONV_DIM = SSD_WIDTH + 2 * SSD_GROUPS * SSD_STATE
IN_DIM = 3 * ATTN_WIDTH + SSD_WIDTH + CONV_DIM + SSD_HEADS

D_FF = 4 * D_MODEL
NORM_EPS = 1e-6

kernel_name = "hymba_moba_ssd_sandwich_trunk"


def rms_norm(x, gain):
    xf = x.astype(jnp.float32)
    inv = lax.rsqrt(jnp.mean(xf * xf, axis=-1, keepdims=True) + NORM_EPS)
    return (xf * inv).astype(x.dtype) * gain


def partial_rope(t, positions):
    half = ROPE_DIM // 2
    inv_freq = ROPE_THETA ** (-jnp.arange(half, dtype=jnp.float32) / half)
    ang = positions.astype(jnp.float32)[:, None, :, None] * inv_freq
    cos, sin = jnp.cos(ang), jnp.sin(ang)
    x1 = t[..., :half]
    x2 = t[..., half:ROPE_DIM]
    rot = jnp.concatenate([x1 * cos - x2 * sin, x2 * cos + x1 * sin], axis=-1).astype(t.dtype)
    return jnp.concatenate([rot, t[..., ROPE_DIM:]], axis=-1)


def moba_attention(q, k, v, positions):
    B_, H, S, Dh = q.shape
    n_blocks = -(-S // MOBA_BLOCK)
    pad = n_blocks * MOBA_BLOCK - S
    q = partial_rope(q, positions) * (Dh ** -0.5)
    k = partial_rope(k, positions)
    kb = jnp.pad(k, ((0, 0), (0, 0), (0, pad), (0, 0))).reshape(B_, H, n_blocks, MOBA_BLOCK, Dh)
    vb = jnp.pad(v, ((0, 0), (0, 0), (0, pad), (0, 0))).reshape(B_, H, n_blocks, MOBA_BLOCK, Dh)
    k_mean = jnp.mean(kb.astype(jnp.float32), axis=3)
    gate = jnp.einsum('bhsd,bhnd->bhsn', q.astype(jnp.float32), k_mean)
    q_block = jnp.arange(S) // MOBA_BLOCK
    past = jnp.arange(n_blocks)[None, :] < q_block[:, None]
    gate = jnp.where(past, gate, -jnp.inf)
    k_sel = min(MOBA_TOPK, n_blocks)
    _, idx = lax.top_k(gate, k_sel)
    valid = idx < q_block[None, None, :, None]

    n_chunks = S // Q_CHUNK
    q_c = q.reshape(B_, H, n_chunks, Q_CHUNK, Dh).transpose(2, 0, 1, 3, 4)
    idx_c = idx.reshape(B_, H, n_chunks, Q_CHUNK, k_sel).transpose(2, 0, 1, 3, 4)
    val_c = valid.reshape(B_, H, n_chunks, Q_CHUNK, k_sel).transpose(2, 0, 1, 3, 4)
    starts = jnp.arange(n_chunks, dtype=jnp.int32) * Q_CHUNK
    b_ix = jnp.arange(B_)[:, None, None, None]
    h_ix = jnp.arange(H)[None, :, None, None]
    key_off = jnp.arange(MOBA_BLOCK)

    def attend_chunk(args):
        qc, ic, vc, start = args
        own = start // MOBA_BLOCK
        k_g = kb[b_ix, h_ix, ic]
        v_g = vb[b_ix, h_ix, ic]
        k_own = lax.dynamic_index_in_dim(kb, own, axis=2, keepdims=False)
        v_own = lax.dynamic_index_in_dim(vb, own, axis=2, keepdims=False)
        s_sel = jnp.einsum('bhqd,bhqjkd->bhqjk', qc, k_g).astype(jnp.float32)
        s_sel = jnp.where(vc[..., None], s_sel, -jnp.inf).reshape(B_, H, Q_CHUNK, k_sel * MOBA_BLOCK)
        s_own = jnp.einsum('bhqd,bhkd->bhqk', qc, k_own).astype(jnp.float32)
        q_pos = start + jnp.arange(Q_CHUNK)
        k_pos = own * MOBA_BLOCK + key_off
        s_own = jnp.where(k_pos[None, :] <= q_pos[:, None], s_own, -jnp.inf)
        p = jax.nn.softmax(jnp.concatenate([s_sel, s_own], axis=-1), axis=-1).astype(v.dtype)
        p_sel = p[..., :k_sel * MOBA_BLOCK].reshape(B_, H, Q_CHUNK, k_sel, MOBA_BLOCK)
        p_own = p[..., k_sel * MOBA_BLOCK:]
        return (jnp.einsum('bhqjk,bhqjkd->bhqd', p_sel, v_g)
                + jnp.einsum('bhqk,bhkd->bhqd', p_own, v_own))

    out = lax.map(attend_chunk, (q_c, idx_c, val_c, starts))
    return out.transpose(1, 2, 0, 3, 4).reshape(B_, H, S, Dh)


def causal_depthwise_conv(x, w, b):
    K, C = w.shape
    out = lax.conv_general_dilated(x, w[:, None, :], window_strides=(1,), padding=[(K - 1, 0)],
                                   dimension_numbers=('NWC', 'WIO', 'NWC'), feature_group_count=C)
    return out + b


def segsum(x):
    T = x.shape[-1]
    xr = jnp.broadcast_to(x[..., :, None], x.shape + (T,))
    xr = jnp.where(jnp.tril(jnp.ones((T, T), dtype=bool), -1), xr, 0.0)
    cs = jnp.cumsum(xr, axis=-2)
    return jnp.where(jnp.tril(jnp.ones((T, T), dtype=bool)), cs, -jnp.inf)


def ssd_scan(x, a_dt, Bm, Cm):
    B_, S, H, P = x.shape
    G, N = Bm.shape[2], Bm.shape[3]
    E = H // G
    L = SSD_CHUNK
    nc = S // L
    xc = x.reshape(B_, nc, L, G, E, P)
    Bc = Bm.reshape(B_, nc, L, G, N)
    Cc = Cm.reshape(B_, nc, L, G, N)
    a = a_dt.reshape(B_, nc, L, G, E).transpose(0, 3, 4, 1, 2)
    a_cs = jnp.cumsum(a, axis=-1)
    decay_in = jnp.exp(segsum(a)).astype(x.dtype)
    cb = jnp.einsum('bclgn,bcsgn->bcgls', Cc, Bc)
    y_diag = jnp.einsum('bcgls,bgecls,bcsgep->bclgep', cb, decay_in, xc)
    decay_to_end = jnp.exp(a_cs[..., -1:] - a_cs).astype(x.dtype)
    chunk_states = jnp.einsum('bclgn,bgecl,bclgep->bcgepn', Bc, decay_to_end, xc)
    chunk_decay = jnp.exp(a_cs[..., -1]).astype(x.dtype)

    def step(state, inp):
        dec, new = inp
        return state * dec[..., None, None] + new, state

    init = jnp.zeros((B_, G, E, P, N), x.dtype)
    _, prev = lax.scan(step, init, (chunk_decay.transpose(3, 0, 1, 2),
                                    chunk_states.transpose(1, 0, 2, 3, 4, 5)))
    prev = prev.transpose(1, 0, 2, 3, 4, 5)
    y_off = jnp.einsum('bclgn,bcgepn,bgecl->bclgep', Cc, prev, jnp.exp(a_cs).astype(x.dtype))
    return (y_diag + y_off).reshape(B_, S, H, P)


def hybrid_mixer(h, positions, w_in, conv_w, conv_b, dt_bias, a_log, d_skip,
                 attn_out_norm, ssd_out_norm, w_out):
    B_, S, _ = h.shape
    proj = h @ w_in
    o1 = ATTN_WIDTH
    o2 = 2 * ATTN_WIDTH
    o3 = 3 * ATTN_WIDTH
    o4 = o3 + SSD_WIDTH
    o5 = o4 + CONV_DIM
    q, k, v, z, xbc, dt = jnp.split(proj, [o1, o2, o3, o4, o5], axis=-1)

    def heads(t):
        return t.reshape(B_, S, ATTN_HEADS, ATTN_HEAD_DIM).transpose(0, 2, 1, 3)
    attn = moba_attention(heads(q), heads(k), heads(v), positions)
    attn = attn.transpose(0, 2, 1, 3).reshape(B_, S, ATTN_WIDTH)
    attn = rms_norm(attn, attn_out_norm)

    xbc = jax.nn.silu(causal_depthwise_conv(xbc, conv_w, conv_b))
    xs, Bm, Cm = jnp.split(xbc, [SSD_WIDTH, SSD_WIDTH + SSD_GROUPS * SSD_STATE], axis=-1)
    dt = jax.nn.softplus(dt.astype(jnp.float32) + dt_bias.astype(jnp.float32))
    a = -jnp.exp(a_log.astype(jnp.float32))
    xh = xs.reshape(B_, S, SSD_HEADS, SSD_HEAD_DIM)
    y = ssd_scan(xh * dt[..., None].astype(xh.dtype), dt * a,
                 Bm.reshape(B_, S, SSD_GROUPS, SSD_STATE), Cm.reshape(B_, S, SSD_GROUPS, SSD_STATE))
    y = y + d_skip[:, None] * xh
    y = y.reshape(B_, S, SSD_WIDTH) * jax.nn.silu(z)
    y = rms_norm(y.reshape(B_, S, SSD_GROUPS, SSD_WIDTH // SSD_GROUPS),
                 ssd_out_norm.reshape(SSD_GROUPS, SSD_WIDTH // SSD_GROUPS)).reshape(B_, S, SSD_WIDTH)

    mix = jnp.concatenate([attn, y], axis=-1)
    return mix @ w_out


def setup_inputs(seed: int = 0) -> dict:
    key = jax.random.key(seed)
    ks = jax.random.split(key, 18)
    f32 = jnp.float32

    def normal(k, shape, scale):
        return jax.random.normal(k, shape, f32) * scale

    def gain(k, shape):
        return 1.0 + 0.05 * jax.random.normal(k, shape, f32)

    x = jax.random.normal(ks[0], (BATCH, SEQ, D_MODEL), f32)
    offset = jax.random.randint(ks[1], (BATCH, 1), 0, 4096, dtype=jnp.int32)
    positions = offset + jnp.arange(SEQ, dtype=jnp.int32)[None, :]
    dt_init = jnp.exp(jax.random.uniform(ks[9], (DEPTH, SSD_HEADS), f32,
                                         math.log(1e-3), math.log(1e-1)))
    dt_bias = dt_init + jnp.log(-jnp.expm1(-dt_init))
    a_log = jnp.log(jax.random.uniform(ks[10], (DEPTH, SSD_HEADS), f32, 1.0, 16.0))
    return {
        "x": x,
        "positions": positions,
        "pre_mix_norm": gain(ks[2], (DEPTH, D_MODEL)),
        "post_mix_norm": gain(ks[3], (DEPTH, D_MODEL)),
        "pre_mlp_norm": gain(ks[4], (DEPTH, D_MODEL)),
        "post_mlp_norm": gain(ks[5], (DEPTH, D_MODEL)),
        "w_in": normal(ks[6], (DEPTH, D_MODEL, IN_DIM), D_MODEL ** -0.5),
        "conv_w": normal(ks[7], (DEPTH, SSD_CONV, CONV_DIM), SSD_CONV ** -0.5),
        "conv_b": normal(ks[8], (DEPTH, CONV_DIM), 0.01),
        "dt_bias": dt_bias,
        "a_log": a_log,
        "d_skip": gain(ks[11], (DEPTH, SSD_HEADS)),
        "attn_out_norm": gain(ks[12], (DEPTH, ATTN_WIDTH)),
        "ssd_out_norm": gain(ks[13], (DEPTH, SSD_WIDTH)),
        "w_out": normal(ks[14], (DEPTH, D_MIX, D_MODEL), D_MIX ** -0.5),
        "w_up": normal(ks[15], (DEPTH, D_MODEL, D_FF), D_MODEL ** -0.5),
        "w_down": normal(ks[16], (DEPTH, D_FF, D_MODEL), D_FF ** -0.5),
    }


def reference(x, positions, pre_mix_norm, post_mix_norm, pre_mlp_norm, post_mlp_norm,
              w_in, conv_w, conv_b, dt_bias, a_log, d_skip, attn_out_norm, ssd_out_norm,
              w_out, w_up, w_down):
    for l in range(DEPTH):
        h = rms_norm(x, pre_mix_norm[l])
        h = hybrid_mixer(h, positions, w_in[l], conv_w[l], conv_b[l], dt_bias[l], a_log[l],
                         d_skip[l], attn_out_norm[l], ssd_out_norm[l], w_out[l])
        x = x + rms_norm(h, post_mix_norm[l])
        h = rms_norm(x, pre_mlp_norm[l])
        h = jnp.square(jax.nn.relu(h @ w_up[l])) @ w_down[l]
        x = x + rms_norm(h, post_mlp_norm[l])
    return x
```

```cpp
#include <hip/hip_runtime.h>
#include <cstdio>
#include <cstdint>
#include <cmath>
namespace pg8 {
#define PG8_LAS __attribute__((address_space(3)))
typedef unsigned short bf16_t;
typedef short bf16x8 __attribute__((ext_vector_type(8)));
typedef float f32x4 __attribute__((ext_vector_type(4)));
typedef unsigned u32x4 __attribute__((ext_vector_type(4)));
constexpr int BM = 256, BK = 64, HALF = 128, HTB = HALF * BK * 2  , STAGE_BYTES = 8 * HTB, NXCD = 8, WGM = 8;

__host__ __device__ __forceinline__ int lds_byte(int r, int c) { const int st = (r >> 4) * 2 + (c >> 5), rr = r & 15, cc = c & 31, ob = rr * 64 + cc * 2; return st * 1024 + (ob ^ (((ob >> 9) & 1) << 5)); }
__host__ __device__ __forceinline__ void stage_rc(int b, int& R, int& C) { const int st = b / 1024, sb = b % 1024, swz = sb ^ (((sb >> 9) & 1) << 5); R = (st >> 1) * 16 + swz / 64; C = (st & 1) * 32 + (swz % 64) / 2; }
__host__ __device__ __forceinline__ int perm32(int rho) { const int n = rho >> 4, i = rho & 15; return 8 * (i >> 2) + 4 * n + (i & 3); }

struct Unit { int pm, pn; };
struct Gemm { const bf16_t* A; const bf16_t* Bt; int M, N, K; };

struct StaticOrder {
    int nM, nN, nwg, G, c;
    __host__ __device__ void init(int M, int N, int G_, int c_) { nM = M / BM; nN = N / BM; nwg = nM * nN; G = G_; c = c_; }
    __host__ __device__ bool next(int i, Unit& u) const {
        const long L = (long)i * G + c; if (L >= nwg) return false;
        int wgid = (int)L; { const int q = nwg / NXCD, r = nwg % NXCD, xcd = wgid % NXCD, off = wgid / NXCD; wgid = (xcd < r ? xcd * (q + 1) : r * (q + 1) + (xcd - r) * q) + off; }
        const int nig = WGM * nN, gid = wgid / nig, fm = gid * WGM, gsz = (nM - fm) < WGM ? (nM - fm) : WGM;
        u.pm = fm + ((wgid % nig) % gsz); u.pn = (wgid % nig) / gsz; return true;
    }
    __device__ __forceinline__ void a_ready(const Unit&) const {}
    __device__ __forceinline__ void done(const Unit&) const {}
};

__device__ __forceinline__ unsigned cvt_pk_bf16(float lo, float hi) { unsigned r; asm volatile("v_cvt_pk_bf16_f32 %0, %1, %2" : "=v"(r) : "v"(lo), "v"(hi)); return r; }

struct EpiF32 {
    static constexpr bool PERM = false, AFTER_DRAIN = false;
    float* C; int ldc;
    __device__ __forceinline__ void operator()(const f32x4 (&acc)[2][2][4][2], const Unit& u, int wr, int wc, int fr, int fq) const {
        const int row0 = u.pm * BM + wr * 64 + fr, col0 = u.pn * BM + wc * 32 + 4 * fq;
#pragma unroll
        for (int ai = 0; ai < 2; ++ai)
#pragma unroll
            for (int m = 0; m < 4; ++m) { float* rowp = C + (size_t)(row0 + ai * HALF + m * 16) * ldc + col0;
#pragma unroll
                for (int bj = 0; bj < 2; ++bj)
#pragma unroll
                    for (int n = 0; n < 2; ++n) *(f32x4*)(rowp + bj * HALF + n * 16) = acc[ai][bj][m][n]; }
    }
};
template <int ACT> struct EpiRowScaleBf16 {
    static constexpr bool PERM = true, AFTER_DRAIN = false;
    bf16_t* O; int ldc; const float* rs;
    __device__ __forceinline__ void operator()(const f32x4 (&acc)[2][2][4][2], const Unit& u, int wr, int wc, int fr, int fq) const {
        const int row0 = u.pm * BM + wr * 64 + fr, col0 = u.pn * BM + wc * 32 + 8 * fq;
#pragma unroll
        for (int ai = 0; ai < 2; ++ai)
#pragma unroll
            for (int m = 0; m < 4; ++m) { const int r = row0 + ai * HALF + m * 16; const float s = rs[r]; bf16_t* rowp = O + (size_t)r * ldc + col0;
#pragma unroll
                for (int bj = 0; bj < 2; ++bj) { f32x4 v0 = acc[ai][bj][m][0] * s, v1 = acc[ai][bj][m][1] * s;
                    if (ACT == 1) {
#pragma unroll
                        for (int j = 0; j < 4; ++j) { const float a = fmaxf(v0[j], 0.f), b = fmaxf(v1[j], 0.f); v0[j] = a * a; v1[j] = b * b; } }
                    u32x4 w; w.x = cvt_pk_bf16(v0[0], v0[1]); w.y = cvt_pk_bf16(v0[2], v0[3]); w.z = cvt_pk_bf16(v1[0], v1[1]); w.w = cvt_pk_bf16(v1[2], v1[3]);
                    *(u32x4*)(rowp + bj * HALF) = w; } }
    }
};

template <class Epi, class Sched, bool ALIGN_EPI = false, bool SP2 = false>
__device__ __forceinline__ void gemm_phase(PG8_LAS unsigned char* lds, const Gemm g, const Sched& S, const Epi& E) {
    int tid_l = threadIdx.x; asm volatile("" : "+v"(tid_l));
    const int tid = tid_l, wid = __builtin_amdgcn_readfirstlane(tid >> 6), lane = tid & 63, wr = wid >> 2, wc = wid & 3, fr = lane & 15, fq = lane >> 4;
    const int K = g.K, nt = K / BK;
    unsigned voffA[2], voffB[2];
#pragma unroll
    for (int i = 0; i < 2; ++i) { int R, C; stage_rc(tid * 16 + i * 8192, R, C); const int Rb = Epi::PERM ? ((R & ~31) + perm32(R & 31)) : R;
        voffA[i] = (unsigned)(R * K + C) * 2u; voffB[i] = (unsigned)(Rb * K + C) * 2u; }
    const size_t kstep = (size_t)(BK * 2);
    const size_t hstep = (size_t)HALF * K * 2;
    const size_t tstep = 2 * hstep;
    const unsigned ldsw = (unsigned)wid * 1024u;
    const int aoff = lds_byte(wr * 64 + fr, fq * 8), boff = lds_byte(wc * 32 + fr, fq * 8);
#define PG8_SA(b, h) (((b) * 2 + (h)) * HTB)
#define PG8_SB(b, h) ((4 + (b) * 2 + (h)) * HTB)
#define PG8_STAGE(bufoff, gbase, voff) do { _Pragma("unroll") for (int _i = 0; _i < 2; ++_i) \
        __builtin_amdgcn_global_load_lds((const unsigned*)((const char*)(gbase) + (voff)[_i]), (PG8_LAS unsigned*)(lds + (bufoff) + ldsw + _i * 8192), 16, 0, 0); } while (0)
#define PG8_LDA(dst, b, h) do { _Pragma("unroll") for (int m = 0; m < 4; ++m) _Pragma("unroll") for (int k = 0; k < 2; ++k) dst[m][k] = *(const PG8_LAS bf16x8*)(lds + PG8_SA(b, h) + aoff + m * 2048 + k * 1024); } while (0)
#define PG8_LDB(dst, b, h) do { _Pragma("unroll") for (int n = 0; n < 2; ++n) _Pragma("unroll") for (int k = 0; k < 2; ++k) dst[n][k] = *(const PG8_LAS bf16x8*)(lds + PG8_SB(b, h) + boff + n * 2048 + k * 1024); } while (0)
#define PG8_MMA(ai, bj, At, Bt) do { __builtin_amdgcn_s_setprio(1); _Pragma("unroll") for (int m = 0; m < 4; ++m) _Pragma("unroll") for (int n = 0; n < 2; ++n) _Pragma("unroll") for (int k = 0; k < 2; ++k) \
        acc[ai][bj][m][n] = __builtin_amdgcn_mfma_f32_16x16x32_bf16(Bt[n][k], At[m][k], acc[ai][bj][m][n], 0, 0, 0); __builtin_amdgcn_s_setprio(0); } while (0)
#define PG8_WAIT_V(n) asm volatile("s_waitcnt vmcnt(" #n ")" ::: "memory")
#define PG8_WAIT_L(n) asm volatile("s_waitcnt lgkmcnt(" #n ")" ::: "memory")
#define PG8_BAR __builtin_amdgcn_s_barrier()
#define PG8_SCHED __builtin_amdgcn_sched_barrier(0)
    Unit cur, nxt; int ui = 0;
    if (!S.next(0, cur)) return;
    f32x4 acc[2][2][4][2];
#pragma unroll
    for (int a = 0; a < 2; ++a)
#pragma unroll
        for (int b = 0; b < 2; ++b)
#pragma unroll
            for (int m = 0; m < 4; ++m)
#pragma unroll
                for (int n = 0; n < 2; ++n) acc[a][b][m][n] = (f32x4){0.f, 0.f, 0.f, 0.f};
    bf16x8 At[4][2], B0[2][2], B1[2][2];
    const char* cA = (const char*)g.A + (size_t)cur.pm * tstep; const char* cB = (const char*)g.Bt + (size_t)cur.pn * tstep;
    S.a_ready(cur);
    if constexpr (SP2) {
        PG8_STAGE(PG8_SB(0, 0), cB, voffB); PG8_STAGE(PG8_SB(0, 1), cB + hstep, voffB); PG8_STAGE(PG8_SA(0, 0), cA, voffA); PG8_STAGE(PG8_SA(0, 1), cA + hstep, voffA);
        if (wr == 1) PG8_BAR;
        PG8_WAIT_V(2); PG8_BAR;
        PG8_STAGE(PG8_SB(1, 0), cB + kstep, voffB); PG8_STAGE(PG8_SA(1, 0), cA + kstep, voffA); PG8_STAGE(PG8_SB(1, 1), cB + hstep + kstep, voffB);
        PG8_WAIT_V(6); PG8_BAR;
    } else {
        PG8_STAGE(PG8_SB(0, 0), cB, voffB); PG8_STAGE(PG8_SA(0, 0), cA, voffA); PG8_STAGE(PG8_SB(0, 1), cB + hstep, voffB); PG8_STAGE(PG8_SA(0, 1), cA + hstep, voffA);
        if (wr == 1) PG8_BAR;
        PG8_WAIT_V(4); PG8_BAR;
        PG8_STAGE(PG8_SB(1, 0), cB + kstep, voffB); PG8_STAGE(PG8_SA(1, 0), cA + kstep, voffA); PG8_STAGE(PG8_SB(1, 1), cB + hstep + kstep, voffB);
        PG8_WAIT_V(6); PG8_BAR;
    }
    for (;;) {
        const bool has_next = S.next(ui + 1, nxt);
        const char* nA = has_next ? (const char*)g.A + (size_t)nxt.pm * tstep : cA; const char* nB = has_next ? (const char*)g.Bt + (size_t)nxt.pn * tstep : cB;
        for (int t = 0; t < nt; t += 2) {
            const bool last = (t == nt - 2);
            const char* a1 = cA + (size_t)(t + 1) * kstep;
            const char* a2 = last ? nA : cA + (size_t)(t + 2) * kstep; const char* b2 = last ? nB : cB + (size_t)(t + 2) * kstep;
            const char* a3 = a2 + kstep; const char* b3 = b2 + kstep;
            if (last && has_next) S.a_ready(nxt);
            if constexpr (SP2) {
            PG8_LDB(B0, 0, 0); PG8_LDB(B1, 0, 1); PG8_SCHED; PG8_LDA(At, 0, 0); PG8_STAGE(PG8_SA(1, 1), a1 + hstep, voffA);
            PG8_WAIT_V(8); PG8_WAIT_L(0); PG8_BAR; PG8_MMA(0, 0, At, B0); PG8_MMA(0, 1, At, B1); PG8_BAR; PG8_SCHED;
            PG8_LDA(At, 0, 1); PG8_STAGE(PG8_SB(0, 0), b2, voffB); PG8_STAGE(PG8_SB(0, 1), b2 + hstep, voffB); PG8_STAGE(PG8_SA(0, 0), a2, voffA);
            PG8_WAIT_V(8); PG8_WAIT_L(0); PG8_BAR; PG8_MMA(1, 0, At, B0); PG8_MMA(1, 1, At, B1); PG8_BAR; PG8_SCHED;
            PG8_LDB(B0, 1, 0); PG8_LDB(B1, 1, 1); PG8_SCHED; PG8_LDA(At, 1, 0); PG8_STAGE(PG8_SA(0, 1), a2 + hstep, voffA);
            PG8_WAIT_V(8); PG8_WAIT_L(0); PG8_BAR; PG8_MMA(0, 0, At, B0); PG8_MMA(0, 1, At, B1); PG8_BAR; PG8_SCHED;
            PG8_LDA(At, 1, 1); PG8_STAGE(PG8_SB(1, 0), b3, voffB); PG8_STAGE(PG8_SB(1, 1), b3 + hstep, voffB); PG8_STAGE(PG8_SA(1, 0), a3, voffA);
            PG8_WAIT_V(8); PG8_WAIT_L(0); PG8_BAR; PG8_MMA(1, 0, At, B0); PG8_MMA(1, 1, At, B1); PG8_BAR; PG8_SCHED;
            } else {
            PG8_LDB(B0, 0, 0); PG8_SCHED; PG8_LDA(At, 0, 0); PG8_STAGE(PG8_SA(1, 1), a1 + hstep, voffA);
            PG8_WAIT_L(8); PG8_BAR; PG8_WAIT_L(0); PG8_MMA(0, 0, At, B0); PG8_BAR; PG8_SCHED;
            PG8_LDB(B1, 0, 1); PG8_STAGE(PG8_SB(0, 0), b2, voffB);
            PG8_BAR; PG8_WAIT_L(0); PG8_MMA(0, 1, At, B1); PG8_BAR;
            PG8_LDA(At, 0, 1); PG8_STAGE(PG8_SA(0, 0), a2, voffA);
            PG8_BAR; PG8_WAIT_L(0); PG8_MMA(1, 0, At, B0); PG8_BAR; PG8_SCHED;
            PG8_STAGE(PG8_SB(0, 1), b2 + hstep, voffB);
            PG8_WAIT_V(6); PG8_BAR; PG8_MMA(1, 1, At, B1); PG8_BAR;
            PG8_LDB(B0, 1, 0); PG8_SCHED; PG8_LDA(At, 1, 0); PG8_STAGE(PG8_SA(0, 1), a2 + hstep, voffA);
            PG8_WAIT_L(8); PG8_BAR; PG8_WAIT_L(0); PG8_MMA(0, 0, At, B0); PG8_BAR; PG8_SCHED;
            PG8_LDB(B1, 1, 1); PG8_STAGE(PG8_SB(1, 0), b3, voffB);
            PG8_BAR; PG8_WAIT_L(0); PG8_MMA(0, 1, At, B1); PG8_BAR;
            PG8_LDA(At, 1, 1); PG8_STAGE(PG8_SA(1, 0), a3, voffA);
            PG8_BAR; PG8_WAIT_L(0); PG8_MMA(1, 0, At, B0); PG8_BAR; PG8_SCHED;
            PG8_STAGE(PG8_SB(1, 1), b3 + hstep, voffB);
            PG8_WAIT_V(6); PG8_BAR; PG8_MMA(1, 1, At, B1); PG8_BAR;
            }
        }
        if constexpr (ALIGN_EPI) { if (wr == 0) PG8_BAR; }
        if constexpr (!Epi::AFTER_DRAIN) { E(acc, cur, wr, wc, fr, fq); S.done(cur); }
        if (!has_next) break;
#pragma unroll
        for (int a = 0; a < 2; ++a)
#pragma unroll
            for (int b = 0; b < 2; ++b)
#pragma unroll
                for (int m = 0; m < 4; ++m)
#pragma unroll
                    for (int n = 0; n < 2; ++n) acc[a][b][m][n] = (f32x4){0.f, 0.f, 0.f, 0.f};
        cur = nxt; cA = nA; cB = nB; ++ui;
        if constexpr (ALIGN_EPI) { if (wr == 1) PG8_BAR; }
    }
    PG8_WAIT_V(0);
    if constexpr (!ALIGN_EPI) { if (wr == 0) PG8_BAR; }
    PG8_BAR;
    if constexpr (Epi::AFTER_DRAIN) { E.fused(acc, cur, wr, wc, fr, fq, lds, wid, lane); S.done(cur); }
#undef PG8_SA
#undef PG8_SB
#undef PG8_STAGE
#undef PG8_LDA
#undef PG8_LDB
#undef PG8_MMA
#undef PG8_WAIT_V
#undef PG8_WAIT_L
#undef PG8_BAR
#undef PG8_SCHED
}
}
#define GAS __attribute__((address_space(1)))
#define LAS __attribute__((address_space(3)))
typedef unsigned short bf16;
typedef unsigned v4u __attribute__((ext_vector_type(4)));
typedef float f32x4 __attribute__((ext_vector_type(4)));
typedef short bf16x8 __attribute__((ext_vector_type(8)));
typedef GAS unsigned gu32;
typedef GAS unsigned long long gu64;
#define RLX_AGENT __ATOMIC_RELAXED, __HIP_MEMORY_SCOPE_AGENT
#define LDS_WAIT() asm volatile("s_waitcnt lgkmcnt(0)" ::: "memory")
#define VM_WAIT() asm volatile("s_waitcnt vmcnt(0)" ::: "memory")
__device__ __forceinline__ unsigned long long rt() { return __builtin_amdgcn_s_memrealtime(); }
__device__ __forceinline__ unsigned f2bf(float f) { unsigned u = __builtin_bit_cast(unsigned, f); return (u + 0x7fffu + ((u >> 16) & 1u)) >> 16; }
__device__ __forceinline__ unsigned pk2(float lo, float hi) { return f2bf(lo) | (f2bf(hi) << 16); }

#define XB_TMO      128
#define XB_XCNT(j)  (256  + 64 * (j))
#define XB_XSUB(j)  (1280 + 64 * (j))
#define XB_XGEN(j)  (2304 + 64 * (j))
#define XB_TOP      3328
#define XB_TOPGEN   3392
#define XCD_BAR_WORDS 3456
#define XB_SPIN_CAP (1u << 22)

__device__ __forceinline__ unsigned xb_ld(unsigned* p)              { return __hip_atomic_load(p, __ATOMIC_RELAXED, __HIP_MEMORY_SCOPE_AGENT); }
__device__ __forceinline__ unsigned xb_add(unsigned* p, unsigned v) { return __hip_atomic_fetch_add(p, v, __ATOMIC_RELAXED, __HIP_MEMORY_SCOPE_AGENT); }
__device__ __forceinline__ unsigned xb_xcc_id() { return (unsigned)__builtin_amdgcn_s_getreg((3 << 11) | 20) & 0xFu; }
#define XB_SPIN(cond, bar) do { unsigned _sp = 0; while (cond) { __builtin_amdgcn_s_sleep(1); \
    if ((++_sp & 255u) == 0u) { if (xb_ld(&(bar)[XB_TMO])) break; if (_sp > XB_SPIN_CAP) { atomicAdd(&(bar)[XB_TMO], 1u); break; } } } } while (0)

struct XcdBarrier {
    unsigned* bar; unsigned x;
    volatile LAS unsigned* st;
};

__device__ __forceinline__ XcdBarrier xcd_barrier_post(unsigned* bar, volatile LAS unsigned* st) {
    XcdBarrier b; b.bar = bar; b.x = xb_xcc_id(); b.st = st;
    if (threadIdx.x == 0) (void)xb_add(&bar[XB_XCNT(b.x)], 1u);
    return b;
}
__device__ __forceinline__ void xcd_barrier_complete(unsigned* bar, unsigned x, unsigned& nloc, unsigned& nx) {
    const unsigned G = gridDim.x * gridDim.y * gridDim.z;
    unsigned sum, cnt, mine, sp = 0u;
    for (;;) {
        sum = 0u; cnt = 0u; mine = 0u;
#pragma unroll
        for (unsigned j = 0; j < 16; ++j) { const unsigned c = xb_ld(&bar[XB_XCNT(j)]); sum += c; cnt += (c > 0u) ? 1u : 0u; mine = (j == x) ? c : mine; }
        if (sum == G) break;
        __builtin_amdgcn_s_sleep(1);
        if ((++sp & 255u) == 0u) { if (xb_ld(&bar[XB_TMO])) break; if (sp > XB_SPIN_CAP) { atomicAdd(&bar[XB_TMO], 1u); break; } }
    }
    nloc = mine > 0u ? mine : 1u; nx = cnt > 0u ? cnt : 1u;
}

__device__ __forceinline__ void xcd_barrier(const XcdBarrier& b) {
    asm volatile("s_waitcnt vmcnt(0)" ::: "memory");
    __syncthreads();
    if (threadIdx.x == 0) {
        unsigned* bar = b.bar;
        __builtin_amdgcn_s_waitcnt(0);
        unsigned nloc = b.st[0], nx = b.st[1];
        if (nloc == 0u) { xcd_barrier_complete(bar, b.x, nloc, nx); b.st[0] = nloc; b.st[1] = nx; }
        const unsigned old = xb_add(&bar[XB_XSUB(b.x)], 1u);
        const unsigned gen = old / nloc;
        if (old + 1u == (gen + 1u) * nloc) {
            __builtin_amdgcn_fence(__ATOMIC_RELEASE, "agent");
            asm volatile("s_waitcnt vmcnt(0)" ::: "memory");
            const unsigned og = xb_add(&bar[XB_TOP], 1u);
            const unsigned tg = og / nx;
            if (og + 1u == (tg + 1u) * nx) xb_add(&bar[XB_TOPGEN], 1u);
            else XB_SPIN(xb_ld(&bar[XB_TOPGEN]) == tg, bar);
            __builtin_amdgcn_fence(__ATOMIC_ACQUIRE, "agent");
            xb_add(&bar[XB_XGEN(b.x)], 1u);
            asm volatile("s_waitcnt vmcnt(0)" ::: "memory");
        } else {
            XB_SPIN(xb_ld(&bar[XB_XGEN(b.x)]) == gen, bar);
            __builtin_amdgcn_fence(__ATOMIC_ACQUIRE, "agent");
            asm volatile("s_waitcnt vmcnt(0)" ::: "memory");
        }
    }
    __syncthreads();
}

constexpr int NWAVES = 8;
constexpr int BATCH = 4, SEQ = 2048, DM = 2048, MTOK = BATCH * SEQ, DEPTH = 4;
constexpr int AW = 1024, NH = 8, HD = 128, MOBA_BLK = 256, NBLK = SEQ / MOBA_BLK;
constexpr int SW = 1024, SH = 16, SP = 64, SN = 128, CONVD = 1536;
constexpr int IN_DIM = 5648, NPROJ = 5888, DFF = 8192;
constexpr int CQ = 0, CK = 1024, CV = 2048, CZ = 3072, CX = 4096, CBm = 5120, CCm = 5376, CDT = 5632;
constexpr float NORM_EPS = 1e-6f;
constexpr float ATT_SCALE = 0.08838834764831845f;

constexpr size_t MiB = 1u << 20;
constexpr size_t WS_CTL = 0, CTL_ZERO_BYTES = 1 * MiB;
constexpr size_t WS_ROPE = 1 * MiB;
constexpr size_t WS_INVA = 2 * MiB, WS_INVB = 2 * MiB + 64 * 1024;
constexpr size_t WS_KMEAN = 2 * MiB + 128 * 1024;
constexpr size_t WS_DT = 3 * MiB;
constexpr size_t WS_WIN = 4 * MiB, WIN_BYTES = (size_t)NPROJ * DM * 2;
constexpr size_t WS_WOUT = 96 * MiB, WOUT_BYTES = (size_t)DM * DM * 2;
constexpr size_t WS_WUP = 128 * MiB, WUP_BYTES = (size_t)DFF * DM * 2;
constexpr size_t WS_WDN = 256 * MiB, WDN_BYTES = (size_t)DM * DFF * 2;
constexpr size_t WS_XB = 384 * MiB;
constexpr size_t WS_PROJ = 416 * MiB;
constexpr size_t WS_MIX = 508 * MiB;
constexpr size_t WS_Y = 540 * MiB;
constexpr size_t WS_HID = 604 * MiB;
constexpr size_t WS_XBC = 732 * MiB;
constexpr size_t WS_YS = 780 * MiB;
constexpr size_t WS_END = 812 * MiB;
static_assert(WS_WIN + 4 * WIN_BYTES <= WS_WOUT && WS_PROJ + (size_t)MTOK * NPROJ * 2 <= WS_MIX, "ws map");
constexpr int CW_BAR = 4096;

constexpr int RING_BYTES = 131072, LDSCTL_OFF = RING_BYTES, MISC_OFF = LDSCTL_OFF + 320, LDS_BYTES = 147456;

typedef unsigned long long u64;
__device__ __forceinline__ float bf2f(bf16 b) { return __uint_as_float(((unsigned)b) << 16); }
__device__ __forceinline__ float wave_sum(float v) {
#pragma unroll
    for (int o = 1; o < 64; o <<= 1) v += __shfl_xor(v, o);
    return v;
}
__device__ __forceinline__ float wave_max(float v) {
#pragma unroll
    for (int o = 1; o < 64; o <<= 1) v = fmaxf(v, __shfl_xor(v, o));
    return v;
}
__device__ __forceinline__ float silu_f(float v) { return v / (1.f + __expf(-v)); }
__device__ __forceinline__ float softplus_f(float v) { return fmaxf(v, 0.f) + log1pf(__expf(-fabsf(v))); }

__device__ __forceinline__ void transpose_item(const float* W, int ldw, int ncols, int K, const float* gain, bf16* WT, LAS float* scr, int item, int lane) {
    const int nblk = ncols / 32, kb = item / nblk, nb = item % nblk, k0 = 64 * kb, n0 = 32 * nb;
#pragma unroll 8
    for (int i = 0; i < 32; ++i) { const int kk = 2 * i + (lane >> 5); float v = W[(size_t)(k0 + kk) * ldw + n0 + (lane & 31)]; if (gain) v *= gain[k0 + kk]; scr[kk * 33 + (lane & 31)] = v; }
    LDS_WAIT(); asm volatile("" ::: "memory");
    const int c = lane & 7;
#pragma unroll
    for (int j = 0; j < 4; ++j) { const int n = (lane >> 3) + 8 * j; const LAS float* s = scr + (8 * c) * 33 + n;
        v4u o; o.x = pk2(s[0 * 33], s[1 * 33]); o.y = pk2(s[2 * 33], s[3 * 33]); o.z = pk2(s[4 * 33], s[5 * 33]); o.w = pk2(s[6 * 33], s[7 * 33]);
        *(GAS v4u*)(WT + (size_t)(n0 + n) * K + k0 + 8 * c) = o; }
    LDS_WAIT(); asm volatile("" ::: "memory");
}

__device__ __forceinline__ void row_update(const float* xrow, const float* yrow, const float* g, float* xo, bf16* xb, float* inv, int lane) {
    f32x4 v[8];
#pragma unroll
    for (int j = 0; j < 8; ++j) v[j] = ((const GAS f32x4*)xrow)[lane + 64 * j];
    if (yrow) {
        f32x4 y[8]; float s = 0.f;
#pragma unroll
        for (int j = 0; j < 8; ++j) { y[j] = ((const GAS f32x4*)yrow)[lane + 64 * j]; s += (y[j].x * y[j].x + y[j].y * y[j].y) + (y[j].z * y[j].z + y[j].w * y[j].w); }
        const float iy = 1.0f / sqrtf(wave_sum(s) * (1.f / DM) + NORM_EPS);
#pragma unroll
        for (int j = 0; j < 8; ++j) { const f32x4 gg = ((const GAS f32x4*)g)[lane + 64 * j]; v[j] = v[j] + (y[j] * iy) * gg; }
    }
    float s2 = 0.f;
#pragma unroll
    for (int j = 0; j < 8; ++j) { s2 += (v[j].x * v[j].x + v[j].y * v[j].y) + (v[j].z * v[j].z + v[j].w * v[j].w);
        ((GAS f32x4*)xo)[lane + 64 * j] = v[j];
        ((GAS u64*)xb)[lane + 64 * j] = (u64)pk2(v[j].x, v[j].y) | ((u64)pk2(v[j].z, v[j].w) << 32); }
    const float ix = 1.0f / sqrtf(wave_sum(s2) * (1.f / DM) + NORM_EPS);
    if (lane == 0) *inv = ix;
}

struct Args { const void* in[17]; float* out; unsigned char* ws; int ph_lo, ph_hi; };
constexpr int NPH_LAYER = 9, NPHASES = 1 + DEPTH * NPH_LAYER;

__global__ void __launch_bounds__(NWAVES * 64, 2) fwd_kernel(Args args) {
    extern __shared__ __attribute__((aligned(16))) unsigned char lds_raw[];
    LAS unsigned char* lds = (LAS unsigned char*)lds_raw;
    volatile LAS unsigned* MISC = (volatile LAS unsigned*)(lds + MISC_OFF);
    const int tid0 = threadIdx.x;
    const int G = gridDim.x, bx = blockIdx.x;
    const int NGW = G * NWAVES, NGT = G * NWAVES * 64;
#define PHASE_LOCALS int tid = tid0; asm volatile("" : "+v"(tid)); const int lane = tid & 63, wave = __builtin_amdgcn_readfirstlane(tid >> 6); \
    const int gw = bx * NWAVES + wave, gt = bx * (NWAVES * 64) + tid; (void)gw; (void)gt; (void)lane;
    unsigned char* ws = args.ws;
    gu32* ctl = (gu32*)(ws + WS_CTL);
    const float* x_in = (const float*)args.in[0]; const int* positions = (const int*)args.in[1];
    const float* pre_mix = (const float*)args.in[2]; const float* post_mix = (const float*)args.in[3];
    const float* pre_mlp = (const float*)args.in[4]; const float* post_mlp = (const float*)args.in[5];
    const float* w_in = (const float*)args.in[6]; const float* conv_w = (const float*)args.in[7]; const float* conv_b = (const float*)args.in[8];
    const float* dt_bias = (const float*)args.in[9]; const float* a_log = (const float*)args.in[10]; const float* d_skip = (const float*)args.in[11];
    const float* attn_norm = (const float*)args.in[12]; const float* ssd_norm = (const float*)args.in[13];
    const float* w_out = (const float*)args.in[14]; const float* w_up = (const float*)args.in[15]; const float* w_down = (const float*)args.in[16];
    float* xres = args.out;
    float2* ROPE = (float2*)(ws + WS_ROPE); float* INVA = (float*)(ws + WS_INVA); float* INVB = (float*)(ws + WS_INVB);
    float* KMEAN = (float*)(ws + WS_KMEAN); float* DTB = (float*)(ws + WS_DT);
    bf16* XB = (bf16*)(ws + WS_XB); bf16* PROJ = (bf16*)(ws + WS_PROJ); bf16* MIX = (bf16*)(ws + WS_MIX); float* Y = (float*)(ws + WS_Y);
    bf16* HID = (bf16*)(ws + WS_HID); float* XBC = (float*)(ws + WS_XBC); float* YS = (float*)(ws + WS_YS);

    for (int u = tid0; u < (LDS_BYTES - LDSCTL_OFF) / 4; u += NWAVES * 64) ((LAS unsigned*)(lds + LDSCTL_OFF))[u] = 0u;
    __syncthreads();
    const int lo = args.ph_lo, hi = args.ph_hi;
    XcdBarrier bar; bar.bar = (unsigned*)(ctl + CW_BAR); bar.x = 0; bar.st = nullptr;
    if (hi - lo > 1) bar = xcd_barrier_post((unsigned*)(ctl + CW_BAR), MISC + 8);
#ifndef PH_MASK
#define PH_MASK 0x3ff
#endif
#define PH_EN(j) ((PH_MASK >> (j)) & 1)
#define IN(k) (lo <= (k) && (k) < hi)
#define BOTH(k) (IN(k) && IN((k) + 1))
#define SEAM(k) do { if (BOTH(k)) xcd_barrier(bar); } while (0)

    if (PH_EN(9) && IN(0)) {
        PHASE_LOCALS
        LAS float* scr = (LAS float*)(lds + wave * 16384);
        constexpr int I_IN = (DM / 64) * (5632 / 32), I_OUT = (DM / 64) * (DM / 32), I_UP = (DM / 64) * (DFF / 32), I_DN = (DFF / 64) * (DM / 32), I_L = I_IN + I_OUT + I_UP + I_DN;
        for (int it = gw; it < DEPTH * I_L; it += NGW) {
            const int l = it / I_L; int r = it % I_L;
            if (r < I_IN) { transpose_item(w_in + (size_t)l * DM * IN_DIM, IN_DIM, 5632, DM, pre_mix + l * DM, (bf16*)(ws + WS_WIN + l * WIN_BYTES), scr, r, lane); continue; } r -= I_IN;
            if (r < I_OUT) { transpose_item(w_out + (size_t)l * DM * DM, DM, DM, DM, nullptr, (bf16*)(ws + WS_WOUT + l * WOUT_BYTES), scr, r, lane); continue; } r -= I_OUT;
            if (r < I_UP) { transpose_item(w_up + (size_t)l * DM * DFF, DFF, DFF, DM, pre_mlp + l * DM, (bf16*)(ws + WS_WUP + l * WUP_BYTES), scr, r, lane); continue; } r -= I_UP;
            transpose_item(w_down + (size_t)l * DFF * DM, DM, DM, DFF, nullptr, (bf16*)(ws + WS_WDN + l * WDN_BYTES), scr, r, lane);
        }
        for (int idx = gt; idx < DEPTH * 256 * DM; idx += NGT) { const int l = idx / (256 * DM), r = idx % (256 * DM), j = r / DM, k = r % DM;
            float v = 0.f; if (j < 16) v = w_in[((size_t)l * DM + k) * IN_DIM + 5632 + j] * pre_mix[l * DM + k];
            ((bf16*)(ws + WS_WIN + l * WIN_BYTES))[(size_t)(5632 + j) * DM + k] = (bf16)f2bf(v); }
        for (int idx = gt; idx < MTOK * 16; idx += NGT) { const int t = idx >> 4, i = idx & 15;
            const float invf = __builtin_amdgcn_exp2f(-(float)i * 1.1832230355827609f);
            const float angf = (float)positions[t] * invf; const double a = (double)angf;
            const double kq = rint(a * 0.63661977236758134); const double yv = fma(-kq, 1.5707963267948966, a) - kq * 6.123233995736766e-17; const int q = ((int)kq) & 3;
            const double y2 = yv * yv;
            const double sn = yv * (1.0 - y2 / 6.0 * (1.0 - y2 / 20.0 * (1.0 - y2 / 42.0 * (1.0 - y2 / 72.0 * (1.0 - y2 / 110.0 * (1.0 - y2 / 156.0))))));
            const double cs = 1.0 - y2 / 2.0 * (1.0 - y2 / 12.0 * (1.0 - y2 / 30.0 * (1.0 - y2 / 56.0 * (1.0 - y2 / 90.0 * (1.0 - y2 / 132.0)))));
            double so, co; if (q == 0) { so = sn; co = cs; } else if (q == 1) { so = cs; co = -sn; } else if (q == 2) { so = -sn; co = -cs; } else { so = -cs; co = sn; }
            ROPE[idx] = make_float2((float)co, (float)so); }
        for (int m = gw; m < MTOK; m += NGW) row_update(x_in + (size_t)m * DM, nullptr, nullptr, xres + (size_t)m * DM, XB + (size_t)m * DM, INVA + m, lane);
        SEAM(0);
    }

    for (int l = 0; l < DEPTH; ++l) {
        const int pb = 1 + NPH_LAYER * l;
        if (PH_EN(0) && IN(pb + 0)) {
            pg8::Gemm g{XB, (const bf16*)(ws + WS_WIN + l * WIN_BYTES), MTOK, NPROJ, DM}; pg8::StaticOrder S; S.init(MTOK, NPROJ, G, bx);
            pg8::EpiRowScaleBf16<0> E{PROJ, NPROJ, INVA};
            pg8::gemm_phase<pg8::EpiRowScaleBf16<0>, pg8::StaticOrder, true, true>(lds, g, S, E);
            SEAM(pb + 0);
        }
        if (PH_EN(1) && IN(pb + 1)) {
            PHASE_LOCALS
            LAS float* part = (LAS float*)lds;
            for (int u = bx; u < BATCH * NH * NBLK; u += G) {
                const int b = u / (NH * NBLK), h = (u / NBLK) % NH, n = u % NBLK;
                const int d = tid & 127, rq = tid >> 7, i16 = d & 15;
                float sum = 0.f;
                for (int i = 0; i < 64; ++i) { const int t = b * SEQ + n * MOBA_BLK + rq * 64 + i;
                    bf16* p = PROJ + (size_t)t * NPROJ + CK + h * HD + d; float v = bf2f(*p);
                    const float o = __shfl_xor(v, 16);
                    if (d < 32) { const float2 cs = ROPE[t * 16 + i16]; const float r = (d < 16) ? (v * cs.x - o * cs.y) : (v * cs.x + o * cs.y); const bf16 rb = (bf16)f2bf(r); *p = rb; v = bf2f(rb); }
                    sum += v; }
                part[rq * 128 + d] = sum;
                __syncthreads();
                if (tid < 128) KMEAN[(size_t)u * 128 + tid] = ((part[tid] + part[128 + tid]) + (part[256 + tid] + part[384 + tid])) * (1.f / 256.f);
                __syncthreads();
            }
            for (int idx = gt; idx < MTOK * NH * 16; idx += NGT) { const int t = idx >> 7, h = (idx >> 4) & 7, i = idx & 15;
                bf16* p = PROJ + (size_t)t * NPROJ + CQ + h * HD + i; const float x1 = bf2f(p[0]), x2 = bf2f(p[16]); const float2 cs = ROPE[t * 16 + i];
                p[0] = (bf16)f2bf(x1 * cs.x - x2 * cs.y); p[16] = (bf16)f2bf(x2 * cs.x + x1 * cs.y); }
            const float* cw = conv_w + (size_t)l * 4 * CONVD; const float* cb = conv_b + (size_t)l * CONVD;
            for (int idx = gt; idx < MTOK * CONVD; idx += NGT) { const int t = idx / CONVD, j = idx % CONVD, s = t % SEQ;
                float a = cb[j];
#pragma unroll
                for (int k = 0; k < 4; ++k) { const int ss = s - 3 + k; if (ss >= 0) a += cw[k * CONVD + j] * bf2f(PROJ[(size_t)(t - 3 + k) * NPROJ + CX + j]); }
                XBC[idx] = silu_f(a); }
            for (int idx = gt; idx < MTOK * SH; idx += NGT) { const int t = idx >> 4, h = idx & 15;
                DTB[idx] = softplus_f(bf2f(PROJ[(size_t)t * NPROJ + CDT + h]) + dt_bias[l * SH + h]); }
            SEAM(pb + 1);
        }
        if (PH_EN(2) && IN(pb + 2)) {
            PHASE_LOCALS
            for (int u = bx; u < BATCH * SH; u += G) {
                const int b = u / SH, h = u % SH, g = h >> 3, p = tid >> 3, nq = tid & 7;
                const float A = -__expf(a_log[l * SH + h]), Dh = d_skip[l * SH + h];
                float st[16];
#pragma unroll
                for (int j = 0; j < 16; ++j) st[j] = 0.f;
                for (int s = 0; s < SEQ; ++s) { const size_t t = (size_t)b * SEQ + s;
                    const float dt = DTB[t * SH + h], xv = XBC[t * CONVD + h * SP + p], dA = __expf(dt * A), dx = dt * xv;
                    const GAS f32x4* Bp = (const GAS f32x4*)(XBC + t * CONVD + 1024 + g * SN + nq * 16); const GAS f32x4* Cp = (const GAS f32x4*)(XBC + t * CONVD + 1280 + g * SN + nq * 16);
                    float yv = 0.f;
#pragma unroll
                    for (int j4 = 0; j4 < 4; ++j4) { const f32x4 bv = Bp[j4], cv = Cp[j4];
#pragma unroll
                        for (int j = 0; j < 4; ++j) { float& sj = st[j4 * 4 + j]; sj = sj * dA + dx * bv[j]; yv += sj * cv[j]; } }
                    yv += __shfl_xor(yv, 1); yv += __shfl_xor(yv, 2); yv += __shfl_xor(yv, 4);
                    if (nq == 0) YS[t * SW + h * SP + p] = yv + Dh * xv; }
            }
            LAS float* qf = (LAS float*)(lds + wave * 8192); LAS float* scl = qf + 128;
            for (int task = gw; task < MTOK * NH; task += NGW) {
                const int t = task >> 3, h = task & 7, b = t >> 11, s = t & (SEQ - 1), qb = s >> 8;
                const unsigned qw = *(const unsigned*)(PROJ + (size_t)t * NPROJ + CQ + h * HD + 2 * lane);
                const float q0 = __uint_as_float(qw << 16), q1 = __uint_as_float(qw & 0xffff0000u);
                qf[2 * lane] = q0; qf[2 * lane + 1] = q1;
                unsigned sel = (1u << qb) - 1u;
                if (qb > 3) { float gate[7];
#pragma unroll
                    for (int n = 0; n < 7; ++n) { float v = 0.f; if (n < qb) { const float2 km = *(const float2*)(KMEAN + ((size_t)(b * NH + h) * NBLK + n) * 128 + 2 * lane); v = q0 * km.x + q1 * km.y; } gate[n] = wave_sum(v); }
                    sel = 0u;
#pragma unroll
                    for (int pick = 0; pick < 3; ++pick) { float best = -__builtin_inff(); int bi = -1;
#pragma unroll
                        for (int n = 0; n < 7; ++n) { const bool ok = (n < qb) && !((sel >> n) & 1u) && (gate[n] > best); if (ok) { best = gate[n]; bi = n; } }
                        if (bi >= 0) sel |= 1u << bi; } }
                unsigned blkpack = 0u; int nb = 0;
#pragma unroll
                for (int n = 0; n < 7; ++n) if ((sel >> n) & 1u) { blkpack |= (unsigned)n << (4 * nb); ++nb; }
                blkpack |= (unsigned)qb << (4 * nb); ++nb;
                LDS_WAIT(); asm volatile("" ::: "memory");
                const int nkeys = nb * 256; float mx = -__builtin_inff();
                for (int i0 = 0; i0 < nkeys; i0 += 64) { const int i = i0 + lane, kb = (blkpack >> (4 * (i0 >> 8))) & 15u, ks = kb * 256 + (i & 255);
                    const GAS v4u* kp = (const GAS v4u*)(PROJ + (size_t)(b * SEQ + ks) * NPROJ + CK + h * HD); float dot = 0.f;
#pragma unroll
                    for (int c = 0; c < 16; ++c) { const v4u kv = kp[c]; const unsigned w4[4] = {kv.x, kv.y, kv.z, kv.w};
#pragma unroll
                        for (int e = 0; e < 4; ++e) dot += qf[c * 8 + 2 * e] * __uint_as_float(w4[e] << 16) + qf[c * 8 + 2 * e + 1] * __uint_as_float(w4[e] & 0xffff0000u); }
                    const float sc = (ks <= s) ? dot * ATT_SCALE : -__builtin_inff(); scl[i] = sc; mx = fmaxf(mx, sc); }
                mx = wave_max(mx);
                LDS_WAIT(); asm volatile("" ::: "memory");
                float lsum = 0.f, a0 = 0.f, a1 = 0.f;
                for (int i = 0; i < nkeys; ++i) { const int kb = (blkpack >> (4 * (i >> 8))) & 15u, ks = kb * 256 + (i & 255);
                    const float pw = __expf(scl[i] - mx); lsum += pw;
                    const unsigned vw = *(const unsigned*)(PROJ + (size_t)(b * SEQ + ks) * NPROJ + CV + h * HD + 2 * lane);
                    a0 += pw * __uint_as_float(vw << 16); a1 += pw * __uint_as_float(vw & 0xffff0000u); }
                const float il = 1.f / lsum;
                *(unsigned*)(MIX + (size_t)t * DM + h * HD + 2 * lane) = pk2(a0 * il, a1 * il);
                LDS_WAIT(); asm volatile("" ::: "memory");
            }
            SEAM(pb + 2);
        }
        if (PH_EN(3) && IN(pb + 3)) {
            PHASE_LOCALS
            for (int t = gw; t < MTOK; t += NGW) {
                { bf16* ar = MIX + (size_t)t * DM; float v[16]; float ss = 0.f;
#pragma unroll
                  for (int hlf = 0; hlf < 2; ++hlf) { const v4u w = *(const GAS v4u*)(ar + hlf * 512 + lane * 8); const unsigned w4[4] = {w.x, w.y, w.z, w.w};
#pragma unroll
                      for (int e = 0; e < 4; ++e) { v[hlf * 8 + 2 * e] = __uint_as_float(w4[e] << 16); v[hlf * 8 + 2 * e + 1] = __uint_as_float(w4[e] & 0xffff0000u); } }
#pragma unroll
                  for (int e = 0; e < 16; ++e) ss += v[e] * v[e];
                  const float inv = 1.0f / sqrtf(wave_sum(ss) * (1.f / AW) + NORM_EPS);
#pragma unroll
                  for (int hlf = 0; hlf < 2; ++hlf) { const float* gp = attn_norm + l * AW + hlf * 512 + lane * 8; v4u o;
                      o.x = pk2(v[hlf * 8 + 0] * inv * gp[0], v[hlf * 8 + 1] * inv * gp[1]); o.y = pk2(v[hlf * 8 + 2] * inv * gp[2], v[hlf * 8 + 3] * inv * gp[3]);
                      o.z = pk2(v[hlf * 8 + 4] * inv * gp[4], v[hlf * 8 + 5] * inv * gp[5]); o.w = pk2(v[hlf * 8 + 6] * inv * gp[6], v[hlf * 8 + 7] * inv * gp[7]);
                      *(GAS v4u*)(ar + hlf * 512 + lane * 8) = o; } }
#pragma unroll
                for (int g = 0; g < 2; ++g) { const int c0 = g * 512 + lane * 8; float v[8]; float ss = 0.f;
                    const v4u zw = *(const GAS v4u*)(PROJ + (size_t)t * NPROJ + CZ + c0); const unsigned z4[4] = {zw.x, zw.y, zw.z, zw.w};
#pragma unroll
                    for (int e = 0; e < 8; ++e) { const float z = (e & 1) ? __uint_as_float(z4[e >> 1] & 0xffff0000u) : __uint_as_float(z4[e >> 1] << 16); v[e] = YS[(size_t)t * SW + c0 + e] * silu_f(z); ss += v[e] * v[e]; }
                    const float inv = 1.0f / sqrtf(wave_sum(ss) * (1.f / 512.f) + NORM_EPS); const float* gp = ssd_norm + l * SW + c0; v4u o;
                    o.x = pk2(v[0] * inv * gp[0], v[1] * inv * gp[1]); o.y = pk2(v[2] * inv * gp[2], v[3] * inv * gp[3]); o.z = pk2(v[4] * inv * gp[4], v[5] * inv * gp[5]); o.w = pk2(v[6] * inv * gp[6], v[7] * inv * gp[7]);
                    *(GAS v4u*)(MIX + (size_t)t * DM + AW + c0) = o; }
            }
            SEAM(pb + 3);
        }
        if (PH_EN(4) && IN(pb + 4)) {
            pg8::Gemm g{MIX, (const bf16*)(ws + WS_WOUT + l * WOUT_BYTES), MTOK, DM, DM}; pg8::StaticOrder S; S.init(MTOK, DM, G, bx);
            pg8::EpiF32 E{Y, DM};
            pg8::gemm_phase<pg8::EpiF32, pg8::StaticOrder, false, true>(lds, g, S, E);
            SEAM(pb + 4);
        }
        if (PH_EN(5) && IN(pb + 5)) {
            PHASE_LOCALS
            for (int m = gw; m < MTOK; m += NGW) row_update(xres + (size_t)m * DM, Y + (size_t)m * DM, post_mix + l * DM, xres + (size_t)m * DM, XB + (size_t)m * DM, INVB + m, lane);
            SEAM(pb + 5);
        }
        if (PH_EN(6) && IN(pb + 6)) {
            pg8::Gemm g{XB, (const bf16*)(ws + WS_WUP + l * WUP_BYTES), MTOK, DFF, DM}; pg8::StaticOrder S; S.init(MTOK, DFF, G, bx);
            pg8::EpiRowScaleBf16<1> E{HID, DFF, INVB};
            pg8::gemm_phase<pg8::EpiRowScaleBf16<1>, pg8::StaticOrder, true, true>(lds, g, S, E);
            SEAM(pb + 6);
        }
        if (PH_EN(7) && IN(pb + 7)) {
            pg8::Gemm g{HID, (const bf16*)(ws + WS_WDN + l * WDN_BYTES), MTOK, DM, DFF}; pg8::StaticOrder S; S.init(MTOK, DM, G, bx);
            pg8::EpiF32 E{Y, DM};
            pg8::gemm_phase<pg8::EpiF32, pg8::StaticOrder, false, true>(lds, g, S, E);
            SEAM(pb + 7);
        }
        if (PH_EN(8) && IN(pb + 8)) {
            PHASE_LOCALS
            for (int m = gw; m < MTOK; m += NGW) row_update(xres + (size_t)m * DM, Y + (size_t)m * DM, post_mlp + l * DM, xres + (size_t)m * DM, XB + (size_t)m * DM, INVA + m, lane);
            SEAM(pb + 8);
        }
    }
#undef IN
#undef BOTH
#undef SEAM
}

#ifndef N_LAUNCH_MODE
#define N_LAUNCH_MODE 0
#endif
extern "C" void kernel_launch(void* const* d_in, const int* in_sizes, int n_in, void* d_out, int out_size, void* d_ws, size_t ws_size, hipStream_t stream) {
    static int grid = 0;
    if (grid == 0) {
        if (n_in != 17 || out_size != MTOK * DM || ws_size < WS_END) { fprintf(stderr, "kernel_launch: unexpected shapes (n_in %d out %d ws %zu)\n", n_in, out_size, ws_size); grid = -1; return; }
        int dev = 0, cus = 0;
        if (hipGetDevice(&dev) != hipSuccess || hipDeviceGetAttribute(&cus, hipDeviceAttributeMultiprocessorCount, dev) != hipSuccess) { grid = -1; return; }
        if (hipFuncSetAttribute((const void*)fwd_kernel, hipFuncAttributeMaxDynamicSharedMemorySize, LDS_BYTES) != hipSuccess) { fprintf(stderr, "kernel_launch: hipFuncSetAttribute failed\n"); grid = -1; return; }
        (void)hipGetLastError();
        grid = cus;
    }
    if (grid < 0) return;
    (void)hipMemsetAsync((char*)d_ws + WS_CTL, 0, CTL_ZERO_BYTES, stream);
    Args a{};
    for (int i = 0; i < 17; ++i) a.in[i] = d_in[i];
    a.out = (float*)d_out; a.ws = (unsigned char*)d_ws;
#if N_LAUNCH_MODE == 1
    a.ph_lo = 0; a.ph_hi = NPHASES;
    hipLaunchKernelGGL(fwd_kernel, dim3(grid), dim3(NWAVES * 64), LDS_BYTES, stream, a);
#else
    for (int p = 0; p < NPHASES; ++p) { a.ph_lo = p; a.ph_hi = p + 1; hipLaunchKernelGGL(fwd_kernel, dim3(grid), dim3(NWAVES * 64), LDS_BYTES, stream, a); }
#endif
}
```

```cpp
#include <hip/hip_runtime.h>
#include <cstdio>
#include <cstdint>
#include <cmath>
#define N_LAUNCH_MODE 1
namespace pg8 {
#define PG8_LAS __attribute__((address_space(3)))
typedef unsigned short bf16_t;
typedef short bf16x8 __attribute__((ext_vector_type(8)));
typedef float f32x4 __attribute__((ext_vector_type(4)));
typedef unsigned u32x4 __attribute__((ext_vector_type(4)));
constexpr int BM = 256, BK = 64, HALF = 128, HTB = HALF * BK * 2  , STAGE_BYTES = 8 * HTB, NXCD = 8, WGM = 8;

__host__ __device__ __forceinline__ int lds_byte(int r, int c) { const int st = (r >> 4) * 2 + (c >> 5), rr = r & 15, cc = c & 31, ob = rr * 64 + cc * 2; return st * 1024 + (ob ^ (((ob >> 9) & 1) << 5)); }
__host__ __device__ __forceinline__ void stage_rc(int b, int& R, int& C) { const int st = b / 1024, sb = b % 1024, swz = sb ^ (((sb >> 9) & 1) << 5); R = (st >> 1) * 16 + swz / 64; C = (st & 1) * 32 + (swz % 64) / 2; }
__host__ __device__ __forceinline__ int perm32(int rho) { const int n = rho >> 4, i = rho & 15; return 8 * (i >> 2) + 4 * n + (i & 3); }

struct Unit { int pm, pn; };
struct Gemm { const bf16_t* A; const bf16_t* Bt; int M, N, K; };

struct StaticOrder {
    int nM, nN, nwg, G, c;
    __host__ __device__ void init(int M, int N, int G_, int c_) { nM = M / BM; nN = N / BM; nwg = nM * nN; G = G_; c = c_; }
    __host__ __device__ bool next(int i, Unit& u) const {
        const long L = (long)i * G + c; if (L >= nwg) return false;
        int wgid = (int)L; { const int q = nwg / NXCD, r = nwg % NXCD, xcd = wgid % NXCD, off = wgid / NXCD; wgid = (xcd < r ? xcd * (q + 1) : r * (q + 1) + (xcd - r) * q) + off; }
        const int nig = WGM * nN, gid = wgid / nig, fm = gid * WGM, gsz = (nM - fm) < WGM ? (nM - fm) : WGM;
        u.pm = fm + ((wgid % nig) % gsz); u.pn = (wgid % nig) / gsz; return true;
    }
    __device__ __forceinline__ void a_ready(const Unit&) const {}
    __device__ __forceinline__ void done(const Unit&) const {}
};

__device__ __forceinline__ unsigned cvt_pk_bf16(float lo, float hi) { unsigned r; asm volatile("v_cvt_pk_bf16_f32 %0, %1, %2" : "=v"(r) : "v"(lo), "v"(hi)); return r; }

struct EpiF32 {
    static constexpr bool PERM = false, AFTER_DRAIN = false;
    float* C; int ldc;
    __device__ __forceinline__ void operator()(const f32x4 (&acc)[2][2][4][2], const Unit& u, int wr, int wc, int fr, int fq) const {
        const int row0 = u.pm * BM + wr * 64 + fr, col0 = u.pn * BM + wc * 32 + 4 * fq;
#pragma unroll
        for (int ai = 0; ai < 2; ++ai)
#pragma unroll
            for (int m = 0; m < 4; ++m) { float* rowp = C + (size_t)(row0 + ai * HALF + m * 16) * ldc + col0;
#pragma unroll
                for (int bj = 0; bj < 2; ++bj)
#pragma unroll
                    for (int n = 0; n < 2; ++n) *(f32x4*)(rowp + bj * HALF + n * 16) = acc[ai][bj][m][n]; }
    }
};
template <int ACT> struct EpiRowScaleBf16 {
    static constexpr bool PERM = true, AFTER_DRAIN = false;
    bf16_t* O; int ldc; const float* rs;
    __device__ __forceinline__ void operator()(const f32x4 (&acc)[2][2][4][2], const Unit& u, int wr, int wc, int fr, int fq) const {
        const int row0 = u.pm * BM + wr * 64 + fr, col0 = u.pn * BM + wc * 32 + 8 * fq;
#pragma unroll
        for (int ai = 0; ai < 2; ++ai)
#pragma unroll
            for (int m = 0; m < 4; ++m) { const int r = row0 + ai * HALF + m * 16; const float s = rs[r]; bf16_t* rowp = O + (size_t)r * ldc + col0;
#pragma unroll
                for (int bj = 0; bj < 2; ++bj) { f32x4 v0 = acc[ai][bj][m][0] * s, v1 = acc[ai][bj][m][1] * s;
                    if (ACT == 1) {
#pragma unroll
                        for (int j = 0; j < 4; ++j) { const float a = fmaxf(v0[j], 0.f), b = fmaxf(v1[j], 0.f); v0[j] = a * a; v1[j] = b * b; } }
                    u32x4 w; w.x = cvt_pk_bf16(v0[0], v0[1]); w.y = cvt_pk_bf16(v0[2], v0[3]); w.z = cvt_pk_bf16(v1[0], v1[1]); w.w = cvt_pk_bf16(v1[2], v1[3]);
                    *(u32x4*)(rowp + bj * HALF) = w; } }
    }
};

template <class Epi, class Sched, bool ALIGN_EPI = false, bool SP2 = false>
__device__ __forceinline__ void gemm_phase(PG8_LAS unsigned char* lds, const Gemm g, const Sched& S, const Epi& E) {
    int tid_l = threadIdx.x; asm volatile("" : "+v"(tid_l));
    const int tid = tid_l, wid = __builtin_amdgcn_readfirstlane(tid >> 6), lane = tid & 63, wr = wid >> 2, wc = wid & 3, fr = lane & 15, fq = lane >> 4;
    const int K = g.K, nt = K / BK;
    unsigned voffA[2], voffB[2];
#pragma unroll
    for (int i = 0; i < 2; ++i) { int R, C; stage_rc(tid * 16 + i * 8192, R, C); const int Rb = Epi::PERM ? ((R & ~31) + perm32(R & 31)) : R;
        voffA[i] = (unsigned)(R * K + C) * 2u; voffB[i] = (unsigned)(Rb * K + C) * 2u; }
    const size_t kstep = (size_t)(BK * 2);
    const size_t hstep = (size_t)HALF * K * 2;
    const size_t tstep = 2 * hstep;
    const unsigned ldsw = (unsigned)wid * 1024u;
    const int aoff = lds_byte(wr * 64 + fr, fq * 8), boff = lds_byte(wc * 32 + fr, fq * 8);
#define PG8_SA(b, h) (((b) * 2 + (h)) * HTB)
#define PG8_SB(b, h) ((4 + (b) * 2 + (h)) * HTB)
#define PG8_STAGE(bufoff, gbase, voff) do { _Pragma("unroll") for (int _i = 0; _i < 2; ++_i) \
        __builtin_amdgcn_global_load_lds((const unsigned*)((const char*)(gbase) + (voff)[_i]), (PG8_LAS unsigned*)(lds + (bufoff) + ldsw + _i * 8192), 16, 0, 0); } while (0)
#define PG8_LDA(dst, b, h) do { _Pragma("unroll") for (int m = 0; m < 4; ++m) _Pragma("unroll") for (int k = 0; k < 2; ++k) dst[m][k] = *(const PG8_LAS bf16x8*)(lds + PG8_SA(b, h) + aoff + m * 2048 + k * 1024); } while (0)
#define PG8_LDB(dst, b, h) do { _Pragma("unroll") for (int n = 0; n < 2; ++n) _Pragma("unroll") for (int k = 0; k < 2; ++k) dst[n][k] = *(const PG8_LAS bf16x8*)(lds + PG8_SB(b, h) + boff + n * 2048 + k * 1024); } while (0)
#define PG8_MMA(ai, bj, At, Bt) do { __builtin_amdgcn_s_setprio(1); _Pragma("unroll") for (int m = 0; m < 4; ++m) _Pragma("unroll") for (int n = 0; n < 2; ++n) _Pragma("unroll") for (int k = 0; k < 2; ++k) \
        acc[ai][bj][m][n] = __builtin_amdgcn_mfma_f32_16x16x32_bf16(Bt[n][k], At[m][k], acc[ai][bj][m][n], 0, 0, 0); __builtin_amdgcn_s_setprio(0); } while (0)
#define PG8_WAIT_V(n) asm volatile("s_waitcnt vmcnt(" #n ")" ::: "memory")
#define PG8_WAIT_L(n) asm volatile("s_waitcnt lgkmcnt(" #n ")" ::: "memory")
#define PG8_BAR __builtin_amdgcn_s_barrier()
#define PG8_SCHED __builtin_amdgcn_sched_barrier(0)
    Unit cur, nxt; int ui = 0;
    if (!S.next(0, cur)) return;
    f32x4 acc[2][2][4][2];
#pragma unroll
    for (int a = 0; a < 2; ++a)
#pragma unroll
        for (int b = 0; b < 2; ++b)
#pragma unroll
            for (int m = 0; m < 4; ++m)
#pragma unroll
                for (int n = 0; n < 2; ++n) acc[a][b][m][n] = (f32x4){0.f, 0.f, 0.f, 0.f};
    bf16x8 At[4][2], B0[2][2], B1[2][2];
    const char* cA = (const char*)g.A + (size_t)cur.pm * tstep; const char* cB = (const char*)g.Bt + (size_t)cur.pn * tstep;
    S.a_ready(cur);
    if constexpr (SP2) {
        PG8_STAGE(PG8_SB(0, 0), cB, voffB); PG8_STAGE(PG8_SB(0, 1), cB + hstep, voffB); PG8_STAGE(PG8_SA(0, 0), cA, voffA); PG8_STAGE(PG8_SA(0, 1), cA + hstep, voffA);
        if (wr == 1) PG8_BAR;
        PG8_WAIT_V(2); PG8_BAR;
        PG8_STAGE(PG8_SB(1, 0), cB + kstep, voffB); PG8_STAGE(PG8_SA(1, 0), cA + kstep, voffA); PG8_STAGE(PG8_SB(1, 1), cB + hstep + kstep, voffB);
        PG8_WAIT_V(6); PG8_BAR;
    } else {
        PG8_STAGE(PG8_SB(0, 0), cB, voffB); PG8_STAGE(PG8_SA(0, 0), cA, voffA); PG8_STAGE(PG8_SB(0, 1), cB + hstep, voffB); PG8_STAGE(PG8_SA(0, 1), cA + hstep, voffA);
        if (wr == 1) PG8_BAR;
        PG8_WAIT_V(4); PG8_BAR;
        PG8_STAGE(PG8_SB(1, 0), cB + kstep, voffB); PG8_STAGE(PG8_SA(1, 0), cA + kstep, voffA); PG8_STAGE(PG8_SB(1, 1), cB + hstep + kstep, voffB);
        PG8_WAIT_V(6); PG8_BAR;
    }
    for (;;) {
        const bool has_next = S.next(ui + 1, nxt);
        const char* nA = has_next ? (const char*)g.A + (size_t)nxt.pm * tstep : cA; const char* nB = has_next ? (const char*)g.Bt + (size_t)nxt.pn * tstep : cB;
        for (int t = 0; t < nt; t += 2) {
            const bool last = (t == nt - 2);
            const char* a1 = cA + (size_t)(t + 1) * kstep;
            const char* a2 = last ? nA : cA + (size_t)(t + 2) * kstep; const char* b2 = last ? nB : cB + (size_t)(t + 2) * kstep;
            const char* a3 = a2 + kstep; const char* b3 = b2 + kstep;
            if (last && has_next) S.a_ready(nxt);
            if constexpr (SP2) {
            PG8_LDB(B0, 0, 0); PG8_LDB(B1, 0, 1); PG8_SCHED; PG8_LDA(At, 0, 0); PG8_STAGE(PG8_SA(1, 1), a1 + hstep, voffA);
            PG8_WAIT_V(8); PG8_WAIT_L(0); PG8_BAR; PG8_MMA(0, 0, At, B0); PG8_MMA(0, 1, At, B1); PG8_BAR; PG8_SCHED;
            PG8_LDA(At, 0, 1); PG8_STAGE(PG8_SB(0, 0), b2, voffB); PG8_STAGE(PG8_SB(0, 1), b2 + hstep, voffB); PG8_STAGE(PG8_SA(0, 0), a2, voffA);
            PG8_WAIT_V(8); PG8_WAIT_L(0); PG8_BAR; PG8_MMA(1, 0, At, B0); PG8_MMA(1, 1, At, B1); PG8_BAR; PG8_SCHED;
            PG8_LDB(B0, 1, 0); PG8_LDB(B1, 1, 1); PG8_SCHED; PG8_LDA(At, 1, 0); PG8_STAGE(PG8_SA(0, 1), a2 + hstep, voffA);
            PG8_WAIT_V(8); PG8_WAIT_L(0); PG8_BAR; PG8_MMA(0, 0, At, B0); PG8_MMA(0, 1, At, B1); PG8_BAR; PG8_SCHED;
            PG8_LDA(At, 1, 1); PG8_STAGE(PG8_SB(1, 0), b3, voffB); PG8_STAGE(PG8_SB(1, 1), b3 + hstep, voffB); PG8_STAGE(PG8_SA(1, 0), a3, voffA);
            PG8_WAIT_V(8); PG8_WAIT_L(0); PG8_BAR; PG8_MMA(1, 0, At, B0); PG8_MMA(1, 1, At, B1); PG8_BAR; PG8_SCHED;
            } else {
            PG8_LDB(B0, 0, 0); PG8_SCHED; PG8_LDA(At, 0, 0); PG8_STAGE(PG8_SA(1, 1), a1 + hstep, voffA);
            PG8_WAIT_L(8); PG8_BAR; PG8_WAIT_L(0); PG8_MMA(0, 0, At, B0); PG8_BAR; PG8_SCHED;
            PG8_LDB(B1, 0, 1); PG8_STAGE(PG8_SB(0, 0), b2, voffB);
            PG8_BAR; PG8_WAIT_L(0); PG8_MMA(0, 1, At, B1); PG8_BAR;
            PG8_LDA(At, 0, 1); PG8_STAGE(PG8_SA(0, 0), a2, voffA);
            PG8_BAR; PG8_WAIT_L(0); PG8_MMA(1, 0, At, B0); PG8_BAR; PG8_SCHED;
            PG8_STAGE(PG8_SB(0, 1), b2 + hstep, voffB);
            PG8_WAIT_V(6); PG8_BAR; PG8_MMA(1, 1, At, B1); PG8_BAR;
            PG8_LDB(B0, 1, 0); PG8_SCHED; PG8_LDA(At, 1, 0); PG8_STAGE(PG8_SA(0, 1), a2 + hstep, voffA);
            PG8_WAIT_L(8); PG8_BAR; PG8_WAIT_L(0); PG8_MMA(0, 0, At, B0); PG8_BAR; PG8_SCHED;
            PG8_LDB(B1, 1, 1); PG8_STAGE(PG8_SB(1, 0), b3, voffB);
            PG8_BAR; PG8_WAIT_L(0); PG8_MMA(0, 1, At, B1); PG8_BAR;
            PG8_LDA(At, 1, 1); PG8_STAGE(PG8_SA(1, 0), a3, voffA);
            PG8_BAR; PG8_WAIT_L(0); PG8_MMA(1, 0, At, B0); PG8_BAR; PG8_SCHED;
            PG8_STAGE(PG8_SB(1, 1), b3 + hstep, voffB);
            PG8_WAIT_V(6); PG8_BAR; PG8_MMA(1, 1, At, B1); PG8_BAR;
            }
        }
        if constexpr (ALIGN_EPI) { if (wr == 0) PG8_BAR; }
        if constexpr (!Epi::AFTER_DRAIN) { E(acc, cur, wr, wc, fr, fq); S.done(cur); }
        if (!has_next) break;
#pragma unroll
        for (int a = 0; a < 2; ++a)
#pragma unroll
            for (int b = 0; b < 2; ++b)
#pragma unroll
                for (int m = 0; m < 4; ++m)
#pragma unroll
                    for (int n = 0; n < 2; ++n) acc[a][b][m][n] = (f32x4){0.f, 0.f, 0.f, 0.f};
        cur = nxt; cA = nA; cB = nB; ++ui;
        if constexpr (ALIGN_EPI) { if (wr == 1) PG8_BAR; }
    }
    PG8_WAIT_V(0);
    if constexpr (!ALIGN_EPI) { if (wr == 0) PG8_BAR; }
    PG8_BAR;
    if constexpr (Epi::AFTER_DRAIN) { E.fused(acc, cur, wr, wc, fr, fq, lds, wid, lane); S.done(cur); }
#undef PG8_SA
#undef PG8_SB
#undef PG8_STAGE
#undef PG8_LDA
#undef PG8_LDB
#undef PG8_MMA
#undef PG8_WAIT_V
#undef PG8_WAIT_L
#undef PG8_BAR
#undef PG8_SCHED
}
}
#define GAS __attribute__((address_space(1)))
#define LAS __attribute__((address_space(3)))
typedef unsigned short bf16;
typedef unsigned v4u __attribute__((ext_vector_type(4)));
typedef float f32x4 __attribute__((ext_vector_type(4)));
typedef short bf16x8 __attribute__((ext_vector_type(8)));
typedef GAS unsigned gu32;
typedef GAS unsigned long long gu64;
#define RLX_AGENT __ATOMIC_RELAXED, __HIP_MEMORY_SCOPE_AGENT
#define LDS_WAIT() asm volatile("s_waitcnt lgkmcnt(0)" ::: "memory")
#define VM_WAIT() asm volatile("s_waitcnt vmcnt(0)" ::: "memory")
__device__ __forceinline__ unsigned long long rt() { return __builtin_amdgcn_s_memrealtime(); }
__device__ __forceinline__ unsigned f2bf(float f) { unsigned u = __builtin_bit_cast(unsigned, f); return (u + 0x7fffu + ((u >> 16) & 1u)) >> 16; }
__device__ __forceinline__ unsigned pk2(float lo, float hi) { return f2bf(lo) | (f2bf(hi) << 16); }

#define XB_TMO      128
#define XB_XCNT(j)  (256  + 64 * (j))
#define XB_XSUB(j)  (1280 + 64 * (j))
#define XB_XGEN(j)  (2304 + 64 * (j))
#define XB_TOP      3328
#define XB_TOPGEN   3392
#define XCD_BAR_WORDS 3456
#define XB_SPIN_CAP (1u << 22)

__device__ __forceinline__ unsigned xb_ld(unsigned* p)              { return __hip_atomic_load(p, __ATOMIC_RELAXED, __HIP_MEMORY_SCOPE_AGENT); }
__device__ __forceinline__ unsigned xb_add(unsigned* p, unsigned v) { return __hip_atomic_fetch_add(p, v, __ATOMIC_RELAXED, __HIP_MEMORY_SCOPE_AGENT); }
__device__ __forceinline__ unsigned xb_xcc_id() { return (unsigned)__builtin_amdgcn_s_getreg((3 << 11) | 20) & 0xFu; }
#define XB_SPIN(cond, bar) do { unsigned _sp = 0; while (cond) { __builtin_amdgcn_s_sleep(1); \
    if ((++_sp & 255u) == 0u) { if (xb_ld(&(bar)[XB_TMO])) break; if (_sp > XB_SPIN_CAP) { atomicAdd(&(bar)[XB_TMO], 1u); break; } } } } while (0)

struct XcdBarrier {
    unsigned* bar; unsigned x;
    volatile LAS unsigned* st;
};

__device__ __forceinline__ XcdBarrier xcd_barrier_post(unsigned* bar, volatile LAS unsigned* st) {
    XcdBarrier b; b.bar = bar; b.x = xb_xcc_id(); b.st = st;
    if (threadIdx.x == 0) (void)xb_add(&bar[XB_XCNT(b.x)], 1u);
    return b;
}
__device__ __forceinline__ void xcd_barrier_complete(unsigned* bar, unsigned x, unsigned& nloc, unsigned& nx) {
    const unsigned G = gridDim.x * gridDim.y * gridDim.z;
    unsigned sum, cnt, mine, sp = 0u;
    for (;;) {
        sum = 0u; cnt = 0u; mine = 0u;
#pragma unroll
        for (unsigned j = 0; j < 16; ++j) { const unsigned c = xb_ld(&bar[XB_XCNT(j)]); sum += c; cnt += (c > 0u) ? 1u : 0u; mine = (j == x) ? c : mine; }
        if (sum == G) break;
        __builtin_amdgcn_s_sleep(1);
        if ((++sp & 255u) == 0u) { if (xb_ld(&bar[XB_TMO])) break; if (sp > XB_SPIN_CAP) { atomicAdd(&bar[XB_TMO], 1u); break; } }
    }
    nloc = mine > 0u ? mine : 1u; nx = cnt > 0u ? cnt : 1u;
}

__device__ __forceinline__ void xcd_barrier(const XcdBarrier& b) {
    asm volatile("s_waitcnt vmcnt(0)" ::: "memory");
    __syncthreads();
    if (threadIdx.x == 0) {
        unsigned* bar = b.bar;
        __builtin_amdgcn_s_waitcnt(0);
        unsigned nloc = b.st[0], nx = b.st[1];
        if (nloc == 0u) { xcd_barrier_complete(bar, b.x, nloc, nx); b.st[0] = nloc; b.st[1] = nx; }
        const unsigned old = xb_add(&bar[XB_XSUB(b.x)], 1u);
        const unsigned gen = old / nloc;
        if (old + 1u == (gen + 1u) * nloc) {
            __builtin_amdgcn_fence(__ATOMIC_RELEASE, "agent");
            asm volatile("s_waitcnt vmcnt(0)" ::: "memory");
            const unsigned og = xb_add(&bar[XB_TOP], 1u);
            const unsigned tg = og / nx;
            if (og + 1u == (tg + 1u) * nx) xb_add(&bar[XB_TOPGEN], 1u);
            else XB_SPIN(xb_ld(&bar[XB_TOPGEN]) == tg, bar);
            __builtin_amdgcn_fence(__ATOMIC_ACQUIRE, "agent");
            xb_add(&bar[XB_XGEN(b.x)], 1u);
            asm volatile("s_waitcnt vmcnt(0)" ::: "memory");
        } else {
            XB_SPIN(xb_ld(&bar[XB_XGEN(b.x)]) == gen, bar);
            __builtin_amdgcn_fence(__ATOMIC_ACQUIRE, "agent");
            asm volatile("s_waitcnt vmcnt(0)" ::: "memory");
        }
    }
    __syncthreads();
}

constexpr int NWAVES = 8;
constexpr int BATCH = 4, SEQ = 2048, DM = 2048, MTOK = BATCH * SEQ, DEPTH = 4;
constexpr int AW = 1024, NH = 8, HD = 128, MOBA_BLK = 256, NBLK = SEQ / MOBA_BLK;
constexpr int SW = 1024, SH = 16, SP = 64, SN = 128, CONVD = 1536;
constexpr int IN_DIM = 5648, NPROJ = 5888, DFF = 8192;
constexpr int CQ = 0, CK = 1024, CV = 2048, CZ = 3072, CX = 4096, CBm = 5120, CCm = 5376, CDT = 5632;
constexpr float NORM_EPS = 1e-6f;
constexpr float ATT_SCALE = 0.08838834764831845f;

constexpr size_t MiB = 1u << 20;
constexpr size_t WS_CTL = 0, CTL_ZERO_BYTES = 1 * MiB;
constexpr size_t WS_ROPE = 1 * MiB;
constexpr size_t WS_INVA = 2 * MiB, WS_INVB = 2 * MiB + 64 * 1024;
constexpr size_t WS_KMEAN = 2 * MiB + 128 * 1024;
constexpr size_t WS_DT = 3 * MiB;
constexpr size_t WS_WIN = 4 * MiB, WIN_BYTES = (size_t)NPROJ * DM * 2;
constexpr size_t WS_WOUT = 96 * MiB, WOUT_BYTES = (size_t)DM * DM * 2;
constexpr size_t WS_WUP = 128 * MiB, WUP_BYTES = (size_t)DFF * DM * 2;
constexpr size_t WS_WDN = 256 * MiB, WDN_BYTES = (size_t)DM * DFF * 2;
constexpr size_t WS_XB = 384 * MiB;
constexpr size_t WS_PROJ = 416 * MiB;
constexpr size_t WS_MIX = 508 * MiB;
constexpr size_t WS_Y = 540 * MiB;
constexpr size_t WS_HID = 604 * MiB;
constexpr size_t WS_XBC = 732 * MiB;
constexpr size_t WS_YS = 780 * MiB;
constexpr size_t WS_END = 812 * MiB;
static_assert(WS_WIN + 4 * WIN_BYTES <= WS_WOUT && WS_PROJ + (size_t)MTOK * NPROJ * 2 <= WS_MIX, "ws map");
constexpr int CW_BAR = 4096;

constexpr int RING_BYTES = 131072, LDSCTL_OFF = RING_BYTES, MISC_OFF = LDSCTL_OFF + 320, LDS_BYTES = 147456;

typedef unsigned long long u64;
__device__ __forceinline__ float bf2f(bf16 b) { return __uint_as_float(((unsigned)b) << 16); }
__device__ __forceinline__ float wave_sum(float v) {
#pragma unroll
    for (int o = 1; o < 64; o <<= 1) v += __shfl_xor(v, o);
    return v;
}
__device__ __forceinline__ float wave_max(float v) {
#pragma unroll
    for (int o = 1; o < 64; o <<= 1) v = fmaxf(v, __shfl_xor(v, o));
    return v;
}
__device__ __forceinline__ float silu_f(float v) { return v / (1.f + __expf(-v)); }
__device__ __forceinline__ float softplus_f(float v) { return fmaxf(v, 0.f) + log1pf(__expf(-fabsf(v))); }

__device__ __forceinline__ void transpose_item(const float* W, int ldw, int ncols, int K, const float* gain, bf16* WT, LAS float* scr, int item, int lane) {
    const int nblk = ncols / 32, kb = item / nblk, nb = item % nblk, k0 = 64 * kb, n0 = 32 * nb;
#pragma unroll 8
    for (int i = 0; i < 32; ++i) { const int kk = 2 * i + (lane >> 5); float v = W[(size_t)(k0 + kk) * ldw + n0 + (lane & 31)]; if (gain) v *= gain[k0 + kk]; scr[kk * 33 + (lane & 31)] = v; }
    LDS_WAIT(); asm volatile("" ::: "memory");
    const int c = lane & 7;
#pragma unroll
    for (int j = 0; j < 4; ++j) { const int n = (lane >> 3) + 8 * j; const LAS float* s = scr + (8 * c) * 33 + n;
        v4u o; o.x = pk2(s[0 * 33], s[1 * 33]); o.y = pk2(s[2 * 33], s[3 * 33]); o.z = pk2(s[4 * 33], s[5 * 33]); o.w = pk2(s[6 * 33], s[7 * 33]);
        *(GAS v4u*)(WT + (size_t)(n0 + n) * K + k0 + 8 * c) = o; }
    LDS_WAIT(); asm volatile("" ::: "memory");
}

__device__ __forceinline__ void row_update(const float* xrow, const float* yrow, const float* g, float* xo, bf16* xb, float* inv, int lane) {
    f32x4 v[8];
#pragma unroll
    for (int j = 0; j < 8; ++j) v[j] = ((const GAS f32x4*)xrow)[lane + 64 * j];
    if (yrow) {
        f32x4 y[8]; float s = 0.f;
#pragma unroll
        for (int j = 0; j < 8; ++j) { y[j] = ((const GAS f32x4*)yrow)[lane + 64 * j]; s += (y[j].x * y[j].x + y[j].y * y[j].y) + (y[j].z * y[j].z + y[j].w * y[j].w); }
        const float iy = 1.0f / sqrtf(wave_sum(s) * (1.f / DM) + NORM_EPS);
#pragma unroll
        for (int j = 0; j < 8; ++j) { const f32x4 gg = ((const GAS f32x4*)g)[lane + 64 * j]; v[j] = v[j] + (y[j] * iy) * gg; }
    }
    float s2 = 0.f;
#pragma unroll
    for (int j = 0; j < 8; ++j) { s2 += (v[j].x * v[j].x + v[j].y * v[j].y) + (v[j].z * v[j].z + v[j].w * v[j].w);
        ((GAS f32x4*)xo)[lane + 64 * j] = v[j];
        ((GAS u64*)xb)[lane + 64 * j] = (u64)pk2(v[j].x, v[j].y) | ((u64)pk2(v[j].z, v[j].w) << 32); }
    const float ix = 1.0f / sqrtf(wave_sum(s2) * (1.f / DM) + NORM_EPS);
    if (lane == 0) *inv = ix;
}

struct Args { const void* in[17]; float* out; unsigned char* ws; int ph_lo, ph_hi; };
constexpr int NPH_LAYER = 9, NPHASES = 1 + DEPTH * NPH_LAYER;

__global__ void __launch_bounds__(NWAVES * 64, 2) fwd_kernel(Args args) {
    extern __shared__ __attribute__((aligned(16))) unsigned char lds_raw[];
    LAS unsigned char* lds = (LAS unsigned char*)lds_raw;
    volatile LAS unsigned* MISC = (volatile LAS unsigned*)(lds + MISC_OFF);
    const int tid0 = threadIdx.x;
    const int G = gridDim.x, bx = blockIdx.x;
    const int NGW = G * NWAVES, NGT = G * NWAVES * 64;
#define PHASE_LOCALS int tid = tid0; asm volatile("" : "+v"(tid)); const int lane = tid & 63, wave = __builtin_amdgcn_readfirstlane(tid >> 6); \
    const int gw = bx * NWAVES + wave, gt = bx * (NWAVES * 64) + tid; (void)gw; (void)gt; (void)lane;
    unsigned char* ws = args.ws;
    gu32* ctl = (gu32*)(ws + WS_CTL);
    const float* x_in = (const float*)args.in[0]; const int* positions = (const int*)args.in[1];
    const float* pre_mix = (const float*)args.in[2]; const float* post_mix = (const float*)args.in[3];
    const float* pre_mlp = (const float*)args.in[4]; const float* post_mlp = (const float*)args.in[5];
    const float* w_in = (const float*)args.in[6]; const float* conv_w = (const float*)args.in[7]; const float* conv_b = (const float*)args.in[8];
    const float* dt_bias = (const float*)args.in[9]; const float* a_log = (const float*)args.in[10]; const float* d_skip = (const float*)args.in[11];
    const float* attn_norm = (const float*)args.in[12]; const float* ssd_norm = (const float*)args.in[13];
    const float* w_out = (const float*)args.in[14]; const float* w_up = (const float*)args.in[15]; const float* w_down = (const float*)args.in[16];
    float* xres = args.out;
    float2* ROPE = (float2*)(ws + WS_ROPE); float* INVA = (float*)(ws + WS_INVA); float* INVB = (float*)(ws + WS_INVB);
    float* KMEAN = (float*)(ws + WS_KMEAN); float* DTB = (float*)(ws + WS_DT);
    bf16* XB = (bf16*)(ws + WS_XB); bf16* PROJ = (bf16*)(ws + WS_PROJ); bf16* MIX = (bf16*)(ws + WS_MIX); float* Y = (float*)(ws + WS_Y);
    bf16* HID = (bf16*)(ws + WS_HID); float* XBC = (float*)(ws + WS_XBC); float* YS = (float*)(ws + WS_YS);

    for (int u = tid0; u < (LDS_BYTES - LDSCTL_OFF) / 4; u += NWAVES * 64) ((LAS unsigned*)(lds + LDSCTL_OFF))[u] = 0u;
    __syncthreads();
    const int lo = args.ph_lo, hi = args.ph_hi;
    XcdBarrier bar; bar.bar = (unsigned*)(ctl + CW_BAR); bar.x = 0; bar.st = nullptr;
    if (hi - lo > 1) bar = xcd_barrier_post((unsigned*)(ctl + CW_BAR), MISC + 8);
#ifndef PH_MASK
#define PH_MASK 0x3ff
#endif
#define PH_EN(j) ((PH_MASK >> (j)) & 1)
#define IN(k) (lo <= (k) && (k) < hi)
#define BOTH(k) (IN(k) && IN((k) + 1))
#define SEAM(k) do { if (BOTH(k)) xcd_barrier(bar); } while (0)

    if (PH_EN(9) && IN(0)) {
        PHASE_LOCALS
        LAS float* scr = (LAS float*)(lds + wave * 16384);
        constexpr int I_IN = (DM / 64) * (5632 / 32), I_OUT = (DM / 64) * (DM / 32), I_UP = (DM / 64) * (DFF / 32), I_DN = (DFF / 64) * (DM / 32), I_L = I_IN + I_OUT + I_UP + I_DN;
        for (int it = gw; it < DEPTH * I_L; it += NGW) {
            const int l = it / I_L; int r = it % I_L;
            if (r < I_IN) { transpose_item(w_in + (size_t)l * DM * IN_DIM, IN_DIM, 5632, DM, pre_mix + l * DM, (bf16*)(ws + WS_WIN + l * WIN_BYTES), scr, r, lane); continue; } r -= I_IN;
            if (r < I_OUT) { transpose_item(w_out + (size_t)l * DM * DM, DM, DM, DM, nullptr, (bf16*)(ws + WS_WOUT + l * WOUT_BYTES), scr, r, lane); continue; } r -= I_OUT;
            if (r < I_UP) { transpose_item(w_up + (size_t)l * DM * DFF, DFF, DFF, DM, pre_mlp + l * DM, (bf16*)(ws + WS_WUP + l * WUP_BYTES), scr, r, lane); continue; } r -= I_UP;
            transpose_item(w_down + (size_t)l * DFF * DM, DM, DM, DFF, nullptr, (bf16*)(ws + WS_WDN + l * WDN_BYTES), scr, r, lane);
        }
        for (int idx = gt; idx < DEPTH * 256 * DM; idx += NGT) { const int l = idx / (256 * DM), r = idx % (256 * DM), j = r / DM, k = r % DM;
            float v = 0.f; if (j < 16) v = w_in[((size_t)l * DM + k) * IN_DIM + 5632 + j] * pre_mix[l * DM + k];
            ((bf16*)(ws + WS_WIN + l * WIN_BYTES))[(size_t)(5632 + j) * DM + k] = (bf16)f2bf(v); }
        for (int idx = gt; idx < MTOK * 16; idx += NGT) { const int t = idx >> 4, i = idx & 15;
            const float invf = __builtin_amdgcn_exp2f(-(float)i * 1.1832230355827609f);
            const float angf = (float)positions[t] * invf; const double a = (double)angf;
            const double kq = rint(a * 0.63661977236758134); const double yv = fma(-kq, 1.5707963267948966, a) - kq * 6.123233995736766e-17; const int q = ((int)kq) & 3;
            const double y2 = yv * yv;
            const double sn = yv * (1.0 - y2 / 6.0 * (1.0 - y2 / 20.0 * (1.0 - y2 / 42.0 * (1.0 - y2 / 72.0 * (1.0 - y2 / 110.0 * (1.0 - y2 / 156.0))))));
            const double cs = 1.0 - y2 / 2.0 * (1.0 - y2 / 12.0 * (1.0 - y2 / 30.0 * (1.0 - y2 / 56.0 * (1.0 - y2 / 90.0 * (1.0 - y2 / 132.0)))));
            double so, co; if (q == 0) { so = sn; co = cs; } else if (q == 1) { so = cs; co = -sn; } else if (q == 2) { so = -sn; co = -cs; } else { so = -cs; co = sn; }
            ROPE[idx] = make_float2((float)co, (float)so); }
        for (int m = gw; m < MTOK; m += NGW) row_update(x_in + (size_t)m * DM, nullptr, nullptr, xres + (size_t)m * DM, XB + (size_t)m * DM, INVA + m, lane);
        SEAM(0);
    }

    for (int l = 0; l < DEPTH; ++l) {
        const int pb = 1 + NPH_LAYER * l;
        if (PH_EN(0) && IN(pb + 0)) {
            pg8::Gemm g{XB, (const bf16*)(ws + WS_WIN + l * WIN_BYTES), MTOK, NPROJ, DM}; pg8::StaticOrder S; S.init(MTOK, NPROJ, G, bx);
            pg8::EpiRowScaleBf16<0> E{PROJ, NPROJ, INVA};
            pg8::gemm_phase<pg8::EpiRowScaleBf16<0>, pg8::StaticOrder, true, true>(lds, g, S, E);
            SEAM(pb + 0);
        }
        if (PH_EN(1) && IN(pb + 1)) {
            PHASE_LOCALS
            LAS float* part = (LAS float*)lds;
            for (int u = bx; u < BATCH * NH * NBLK; u += G) {
                const int b = u / (NH * NBLK), h = (u / NBLK) % NH, n = u % NBLK;
                const int d = tid & 127, rq = tid >> 7, i16 = d & 15;
                float sum = 0.f;
                for (int i = 0; i < 64; ++i) { const int t = b * SEQ + n * MOBA_BLK + rq * 64 + i;
                    bf16* p = PROJ + (size_t)t * NPROJ + CK + h * HD + d; float v = bf2f(*p);
                    const float o = __shfl_xor(v, 16);
                    if (d < 32) { const float2 cs = ROPE[t * 16 + i16]; const float r = (d < 16) ? (v * cs.x - o * cs.y) : (v * cs.x + o * cs.y); const bf16 rb = (bf16)f2bf(r); *p = rb; v = bf2f(rb); }
                    sum += v; }
                part[rq * 128 + d] = sum;
                __syncthreads();
                if (tid < 128) KMEAN[(size_t)u * 128 + tid] = ((part[tid] + part[128 + tid]) + (part[256 + tid] + part[384 + tid])) * (1.f / 256.f);
                __syncthreads();
            }
            for (int idx = gt; idx < MTOK * NH * 16; idx += NGT) { const int t = idx >> 7, h = (idx >> 4) & 7, i = idx & 15;
                bf16* p = PROJ + (size_t)t * NPROJ + CQ + h * HD + i; const float x1 = bf2f(p[0]), x2 = bf2f(p[16]); const float2 cs = ROPE[t * 16 + i];
                p[0] = (bf16)f2bf(x1 * cs.x - x2 * cs.y); p[16] = (bf16)f2bf(x2 * cs.x + x1 * cs.y); }
            const float* cw = conv_w + (size_t)l * 4 * CONVD; const float* cb = conv_b + (size_t)l * CONVD;
            for (int idx = gt; idx < MTOK * CONVD; idx += NGT) { const int t = idx / CONVD, j = idx % CONVD, s = t % SEQ;
                float a = cb[j];
#pragma unroll
                for (int k = 0; k < 4; ++k) { const int ss = s - 3 + k; if (ss >= 0) a += cw[k * CONVD + j] * bf2f(PROJ[(size_t)(t - 3 + k) * NPROJ + CX + j]); }
                XBC[idx] = silu_f(a); }
            for (int idx = gt; idx < MTOK * SH; idx += NGT) { const int t = idx >> 4, h = idx & 15;
                DTB[idx] = softplus_f(bf2f(PROJ[(size_t)t * NPROJ + CDT + h]) + dt_bias[l * SH + h]); }
            SEAM(pb + 1);
        }
        if (PH_EN(2) && IN(pb + 2)) {
            PHASE_LOCALS
            for (int u = bx; u < BATCH * SH; u += G) {
                const int b = u / SH, h = u % SH, g = h >> 3, p = tid >> 3, nq = tid & 7;
                const float A = -__expf(a_log[l * SH + h]), Dh = d_skip[l * SH + h];
                float st[16];
#pragma unroll
                for (int j = 0; j < 16; ++j) st[j] = 0.f;
                for (int s = 0; s < SEQ; ++s) { const size_t t = (size_t)b * SEQ + s;
                    const float dt = DTB[t * SH + h], xv = XBC[t * CONVD + h * SP + p], dA = __expf(dt * A), dx = dt * xv;
                    const GAS f32x4* Bp = (const GAS f32x4*)(XBC + t * CONVD + 1024 + g * SN + nq * 16); const GAS f32x4* Cp = (const GAS f32x4*)(XBC + t * CONVD + 1280 + g * SN + nq * 16);
                    float yv = 0.f;
#pragma unroll
                    for (int j4 = 0; j4 < 4; ++j4) { const f32x4 bv = Bp[j4], cv = Cp[j4];
#pragma unroll
                        for (int j = 0; j < 4; ++j) { float& sj = st[j4 * 4 + j]; sj = sj * dA + dx * bv[j]; yv += sj * cv[j]; } }
                    yv += __shfl_xor(yv, 1); yv += __shfl_xor(yv, 2); yv += __shfl_xor(yv, 4);
                    if (nq == 0) YS[t * SW + h * SP + p] = yv + Dh * xv; }
            }
            LAS float* qf = (LAS float*)(lds + wave * 8192); LAS float* scl = qf + 128;
            for (int task = gw; task < MTOK * NH; task += NGW) {
                const int t = task >> 3, h = task & 7, b = t >> 11, s = t & (SEQ - 1), qb = s >> 8;
                const unsigned qw = *(const unsigned*)(PROJ + (size_t)t * NPROJ + CQ + h * HD + 2 * lane);
                const float q0 = __uint_as_float(qw << 16), q1 = __uint_as_float(qw & 0xffff0000u);
                qf[2 * lane] = q0; qf[2 * lane + 1] = q1;
                unsigned sel = (1u << qb) - 1u;
                if (qb > 3) { float gate[7];
#pragma unroll
                    for (int n = 0; n < 7; ++n) { float v = 0.f; if (n < qb) { const float2 km = *(const float2*)(KMEAN + ((size_t)(b * NH + h) * NBLK + n) * 128 + 2 * lane); v = q0 * km.x + q1 * km.y; } gate[n] = wave_sum(v); }
                    sel = 0u;
#pragma unroll
                    for (int pick = 0; pick < 3; ++pick) { float best = -__builtin_inff(); int bi = -1;
#pragma unroll
                        for (int n = 0; n < 7; ++n) { const bool ok = (n < qb) && !((sel >> n) & 1u) && (gate[n] > best); if (ok) { best = gate[n]; bi = n; } }
                        if (bi >= 0) sel |= 1u << bi; } }
                unsigned blkpack = 0u; int nb = 0;
#pragma unroll
                for (int n = 0; n < 7; ++n) if ((sel >> n) & 1u) { blkpack |= (unsigned)n << (4 * nb); ++nb; }
                blkpack |= (unsigned)qb << (4 * nb); ++nb;
                LDS_WAIT(); asm volatile("" ::: "memory");
                const int nkeys = nb * 256; float mx = -__builtin_inff();
                for (int i0 = 0; i0 < nkeys; i0 += 64) { const int i = i0 + lane, kb = (blkpack >> (4 * (i0 >> 8))) & 15u, ks = kb * 256 + (i & 255);
                    const GAS v4u* kp = (const GAS v4u*)(PROJ + (size_t)(b * SEQ + ks) * NPROJ + CK + h * HD); float dot = 0.f;
#pragma unroll
                    for (int c = 0; c < 16; ++c) { const v4u kv = kp[c]; const unsigned w4[4] = {kv.x, kv.y, kv.z, kv.w};
#pragma unroll
                        for (int e = 0; e < 4; ++e) dot += qf[c * 8 + 2 * e] * __uint_as_float(w4[e] << 16) + qf[c * 8 + 2 * e + 1] * __uint_as_float(w4[e] & 0xffff0000u); }
                    const float sc = (ks <= s) ? dot * ATT_SCALE : -__builtin_inff(); scl[i] = sc; mx = fmaxf(mx, sc); }
                mx = wave_max(mx);
                LDS_WAIT(); asm volatile("" ::: "memory");
                float lsum = 0.f, a0 = 0.f, a1 = 0.f;
                for (int i = 0; i < nkeys; ++i) { const int kb = (blkpack >> (4 * (i >> 8))) & 15u, ks = kb * 256 + (i & 255);
                    const float pw = __expf(scl[i] - mx); lsum += pw;
                    const unsigned vw = *(const unsigned*)(PROJ + (size_t)(b * SEQ + ks) * NPROJ + CV + h * HD + 2 * lane);
                    a0 += pw * __uint_as_float(vw << 16); a1 += pw * __uint_as_float(vw & 0xffff0000u); }
                const float il = 1.f / lsum;
                *(unsigned*)(MIX + (size_t)t * DM + h * HD + 2 * lane) = pk2(a0 * il, a1 * il);
                LDS_WAIT(); asm volatile("" ::: "memory");
            }
            SEAM(pb + 2);
        }
        if (PH_EN(3) && IN(pb + 3)) {
            PHASE_LOCALS
            for (int t = gw; t < MTOK; t += NGW) {
                { bf16* ar = MIX + (size_t)t * DM; float v[16]; float ss = 0.f;
#pragma unroll
                  for (int hlf = 0; hlf < 2; ++hlf) { const v4u w = *(const GAS v4u*)(ar + hlf * 512 + lane * 8); const unsigned w4[4] = {w.x, w.y, w.z, w.w};
#pragma unroll
                      for (int e = 0; e < 4; ++e) { v[hlf * 8 + 2 * e] = __uint_as_float(w4[e] << 16); v[hlf * 8 + 2 * e + 1] = __uint_as_float(w4[e] & 0xffff0000u); } }
#pragma unroll
                  for (int e = 0; e < 16; ++e) ss += v[e] * v[e];
                  const float inv = 1.0f / sqrtf(wave_sum(ss) * (1.f / AW) + NORM_EPS);
#pragma unroll
                  for (int hlf = 0; hlf < 2; ++hlf) { const float* gp = attn_norm + l * AW + hlf * 512 + lane * 8; v4u o;
                      o.x = pk2(v[hlf * 8 + 0] * inv * gp[0], v[hlf * 8 + 1] * inv * gp[1]); o.y = pk2(v[hlf * 8 + 2] * inv * gp[2], v[hlf * 8 + 3] * inv * gp[3]);
                      o.z = pk2(v[hlf * 8 + 4] * inv * gp[4], v[hlf * 8 + 5] * inv * gp[5]); o.w = pk2(v[hlf * 8 + 6] * inv * gp[6], v[hlf * 8 + 7] * inv * gp[7]);
                      *(GAS v4u*)(ar + hlf * 512 + lane * 8) = o; } }
#pragma unroll
                for (int g = 0; g < 2; ++g) { const int c0 = g * 512 + lane * 8; float v[8]; float ss = 0.f;
                    const v4u zw = *(const GAS v4u*)(PROJ + (size_t)t * NPROJ + CZ + c0); const unsigned z4[4] = {zw.x, zw.y, zw.z, zw.w};
#pragma unroll
                    for (int e = 0; e < 8; ++e) { const float z = (e & 1) ? __uint_as_float(z4[e >> 1] & 0xffff0000u) : __uint_as_float(z4[e >> 1] << 16); v[e] = YS[(size_t)t * SW + c0 + e] * silu_f(z); ss += v[e] * v[e]; }
                    const float inv = 1.0f / sqrtf(wave_sum(ss) * (1.f / 512.f) + NORM_EPS); const float* gp = ssd_norm + l * SW + c0; v4u o;
                    o.x = pk2(v[0] * inv * gp[0], v[1] * inv * gp[1]); o.y = pk2(v[2] * inv * gp[2], v[3] * inv * gp[3]); o.z = pk2(v[4] * inv * gp[4], v[5] * inv * gp[5]); o.w = pk2(v[6] * inv * gp[6], v[7] * inv * gp[7]);
                    *(GAS v4u*)(MIX + (size_t)t * DM + AW + c0) = o; }
            }
            SEAM(pb + 3);
        }
        if (PH_EN(4) && IN(pb + 4)) {
            pg8::Gemm g{MIX, (const bf16*)(ws + WS_WOUT + l * WOUT_BYTES), MTOK, DM, DM}; pg8::StaticOrder S; S.init(MTOK, DM, G, bx);
            pg8::EpiF32 E{Y, DM};
            pg8::gemm_phase<pg8::EpiF32, pg8::StaticOrder, false, true>(lds, g, S, E);
            SEAM(pb + 4);
        }
        if (PH_EN(5) && IN(pb + 5)) {
            PHASE_LOCALS
            for (int m = gw; m < MTOK; m += NGW) row_update(xres + (size_t)m * DM, Y + (size_t)m * DM, post_mix + l * DM, xres + (size_t)m * DM, XB + (size_t)m * DM, INVB + m, lane);
            SEAM(pb + 5);
        }
        if (PH_EN(6) && IN(pb + 6)) {
            pg8::Gemm g{XB, (const bf16*)(ws + WS_WUP + l * WUP_BYTES), MTOK, DFF, DM}; pg8::StaticOrder S; S.init(MTOK, DFF, G, bx);
            pg8::EpiRowScaleBf16<1> E{HID, DFF, INVB};
            pg8::gemm_phase<pg8::EpiRowScaleBf16<1>, pg8::StaticOrder, true, true>(lds, g, S, E);
            SEAM(pb + 6);
        }
        if (PH_EN(7) && IN(pb + 7)) {
            pg8::Gemm g{HID, (const bf16*)(ws + WS_WDN + l * WDN_BYTES), MTOK, DM, DFF}; pg8::StaticOrder S; S.init(MTOK, DM, G, bx);
            pg8::EpiF32 E{Y, DM};
            pg8::gemm_phase<pg8::EpiF32, pg8::StaticOrder, false, true>(lds, g, S, E);
            SEAM(pb + 7);
        }
        if (PH_EN(8) && IN(pb + 8)) {
            PHASE_LOCALS
            for (int m = gw; m < MTOK; m += NGW) row_update(xres + (size_t)m * DM, Y + (size_t)m * DM, post_mlp + l * DM, xres + (size_t)m * DM, XB + (size_t)m * DM, INVA + m, lane);
            SEAM(pb + 8);
        }
    }
#undef IN
#undef BOTH
#undef SEAM
}

#ifndef N_LAUNCH_MODE
#define N_LAUNCH_MODE 0
#endif
extern "C" void kernel_launch(void* const* d_in, const int* in_sizes, int n_in, void* d_out, int out_size, void* d_ws, size_t ws_size, hipStream_t stream) {
    static int grid = 0;
    if (grid == 0) {
        if (n_in != 17 || out_size != MTOK * DM || ws_size < WS_END) { fprintf(stderr, "kernel_launch: unexpected shapes (n_in %d out %d ws %zu)\n", n_in, out_size, ws_size); grid = -1; return; }
        int dev = 0, cus = 0;
        if (hipGetDevice(&dev) != hipSuccess || hipDeviceGetAttribute(&cus, hipDeviceAttributeMultiprocessorCount, dev) != hipSuccess) { grid = -1; return; }
        if (hipFuncSetAttribute((const void*)fwd_kernel, hipFuncAttributeMaxDynamicSharedMemorySize, LDS_BYTES) != hipSuccess) { fprintf(stderr, "kernel_launch: hipFuncSetAttribute failed\n"); grid = -1; return; }
        (void)hipGetLastError();
        grid = cus;
    }
    if (grid < 0) return;
    (void)hipMemsetAsync((char*)d_ws + WS_CTL, 0, CTL_ZERO_BYTES, stream);
    Args a{};
    for (int i = 0; i < 17; ++i) a.in[i] = d_in[i];
    a.out = (float*)d_out; a.ws = (unsigned char*)d_ws;
#if N_LAUNCH_MODE == 1
    a.ph_lo = 0; a.ph_hi = NPHASES;
    hipLaunchKernelGGL(fwd_kernel, dim3(grid), dim3(NWAVES * 64), LDS_BYTES, stream, a);
#else
    for (int p = 0; p < NPHASES; ++p) { a.ph_lo = p; a.ph_hi = p + 1; hipLaunchKernelGGL(fwd_kernel, dim3(grid), dim3(NWAVES * 64), LDS_BYTES, stream, a); }
#endif
}
```

```cpp
#include <hip/hip_runtime.h>
#include <cstdio>
#include <cstdint>
#include <cmath>
#define N_LAUNCH_MODE 1
namespace pg8 {
#define PG8_LAS __attribute__((address_space(3)))
typedef unsigned short bf16_t;
typedef short bf16x8 __attribute__((ext_vector_type(8)));
typedef float f32x4 __attribute__((ext_vector_type(4)));
typedef unsigned u32x4 __attribute__((ext_vector_type(4)));
constexpr int BM = 256, BK = 64, HALF = 128, HTB = HALF * BK * 2  , STAGE_BYTES = 8 * HTB, NXCD = 8, WGM = 8;

__host__ __device__ __forceinline__ int lds_byte(int r, int c) { const int st = (r >> 4) * 2 + (c >> 5), rr = r & 15, cc = c & 31, ob = rr * 64 + cc * 2; return st * 1024 + (ob ^ (((ob >> 9) & 1) << 5)); }
__host__ __device__ __forceinline__ void stage_rc(int b, int& R, int& C) { const int st = b / 1024, sb = b % 1024, swz = sb ^ (((sb >> 9) & 1) << 5); R = (st >> 1) * 16 + swz / 64; C = (st & 1) * 32 + (swz % 64) / 2; }
__host__ __device__ __forceinline__ int perm32(int rho) { const int n = rho >> 4, i = rho & 15; return 8 * (i >> 2) + 4 * n + (i & 3); }

struct Unit { int pm, pn; };
struct Gemm { const bf16_t* A; const bf16_t* Bt; int M, N, K; };

struct StaticOrder {
    int nM, nN, nwg, G, c;
    __host__ __device__ void init(int M, int N, int G_, int c_) { nM = M / BM; nN = N / BM; nwg = nM * nN; G = G_; c = c_; }
    __host__ __device__ bool next(int i, Unit& u) const {
        const long L = (long)i * G + c; if (L >= nwg) return false;
        int wgid = (int)L; { const int q = nwg / NXCD, r = nwg % NXCD, xcd = wgid % NXCD, off = wgid / NXCD; wgid = (xcd < r ? xcd * (q + 1) : r * (q + 1) + (xcd - r) * q) + off; }
        const int nig = WGM * nN, gid = wgid / nig, fm = gid * WGM, gsz = (nM - fm) < WGM ? (nM - fm) : WGM;
        u.pm = fm + ((wgid % nig) % gsz); u.pn = (wgid % nig) / gsz; return true;
    }
    __device__ __forceinline__ void a_ready(const Unit&) const {}
    __device__ __forceinline__ void done(const Unit&) const {}
};

__device__ __forceinline__ unsigned cvt_pk_bf16(float lo, float hi) { unsigned r; asm volatile("v_cvt_pk_bf16_f32 %0, %1, %2" : "=v"(r) : "v"(lo), "v"(hi)); return r; }

struct EpiF32 {
    static constexpr bool PERM = false, AFTER_DRAIN = false;
    float* C; int ldc;
    __device__ __forceinline__ void operator()(const f32x4 (&acc)[2][2][4][2], const Unit& u, int wr, int wc, int fr, int fq) const {
        const int row0 = u.pm * BM + wr * 64 + fr, col0 = u.pn * BM + wc * 32 + 4 * fq;
#pragma unroll
        for (int ai = 0; ai < 2; ++ai)
#pragma unroll
            for (int m = 0; m < 4; ++m) { float* rowp = C + (size_t)(row0 + ai * HALF + m * 16) * ldc + col0;
#pragma unroll
                for (int bj = 0; bj < 2; ++bj)
#pragma unroll
                    for (int n = 0; n < 2; ++n) *(f32x4*)(rowp + bj * HALF + n * 16) = acc[ai][bj][m][n]; }
    }
};
template <int ACT> struct EpiRowScaleBf16 {
    static constexpr bool PERM = true, AFTER_DRAIN = false;
    bf16_t* O; int ldc; const float* rs;
    __device__ __forceinline__ void operator()(const f32x4 (&acc)[2][2][4][2], const Unit& u, int wr, int wc, int fr, int fq) const {
        const int row0 = u.pm * BM + wr * 64 + fr, col0 = u.pn * BM + wc * 32 + 8 * fq;
#pragma unroll
        for (int ai = 0; ai < 2; ++ai)
#pragma unroll
            for (int m = 0; m < 4; ++m) { const int r = row0 + ai * HALF + m * 16; const float s = rs[r]; bf16_t* rowp = O + (size_t)r * ldc + col0;
#pragma unroll
                for (int bj = 0; bj < 2; ++bj) { f32x4 v0 = acc[ai][bj][m][0] * s, v1 = acc[ai][bj][m][1] * s;
                    if (ACT == 1) {
#pragma unroll
                        for (int j = 0; j < 4; ++j) { const float a = fmaxf(v0[j], 0.f), b = fmaxf(v1[j], 0.f); v0[j] = a * a; v1[j] = b * b; } }
                    u32x4 w; w.x = cvt_pk_bf16(v0[0], v0[1]); w.y = cvt_pk_bf16(v0[2], v0[3]); w.z = cvt_pk_bf16(v1[0], v1[1]); w.w = cvt_pk_bf16(v1[2], v1[3]);
                    *(u32x4*)(rowp + bj * HALF) = w; } }
    }
};

template <class Epi, class Sched, bool ALIGN_EPI = false, bool SP2 = false>
__device__ __forceinline__ void gemm_phase(PG8_LAS unsigned char* lds, const Gemm g, const Sched& S, const Epi& E) {
    int tid_l = threadIdx.x; asm volatile("" : "+v"(tid_l));
    const int tid = tid_l, wid = __builtin_amdgcn_readfirstlane(tid >> 6), lane = tid & 63, wr = wid >> 2, wc = wid & 3, fr = lane & 15, fq = lane >> 4;
    const int K = g.K, nt = K / BK;
    unsigned voffA[2], voffB[2];
#pragma unroll
    for (int i = 0; i < 2; ++i) { int R, C; stage_rc(tid * 16 + i * 8192, R, C); const int Rb = Epi::PERM ? ((R & ~31) + perm32(R & 31)) : R;
        voffA[i] = (unsigned)(R * K + C) * 2u; voffB[i] = (unsigned)(Rb * K + C) * 2u; }
    const size_t kstep = (size_t)(BK * 2);
    const size_t hstep = (size_t)HALF * K * 2;
    const size_t tstep = 2 * hstep;
    const unsigned ldsw = (unsigned)wid * 1024u;
    const int aoff = lds_byte(wr * 64 + fr, fq * 8), boff = lds_byte(wc * 32 + fr, fq * 8);
#define PG8_SA(b, h) (((b) * 2 + (h)) * HTB)
#define PG8_SB(b, h) ((4 + (b) * 2 + (h)) * HTB)
#define PG8_STAGE(bufoff, gbase, voff) do { _Pragma("unroll") for (int _i = 0; _i < 2; ++_i) \
        __builtin_amdgcn_global_load_lds((const unsigned*)((const char*)(gbase) + (voff)[_i]), (PG8_LAS unsigned*)(lds + (bufoff) + ldsw + _i * 8192), 16, 0, 0); } while (0)
#define PG8_LDA(dst, b, h) do { _Pragma("unroll") for (int m = 0; m < 4; ++m) _Pragma("unroll") for (int k = 0; k < 2; ++k) dst[m][k] = *(const PG8_LAS bf16x8*)(lds + PG8_SA(b, h) + aoff + m * 2048 + k * 1024); } while (0)
#define PG8_LDB(dst, b, h) do { _Pragma("unroll") for (int n = 0; n < 2; ++n) _Pragma("unroll") for (int k = 0; k < 2; ++k) dst[n][k] = *(const PG8_LAS bf16x8*)(lds + PG8_SB(b, h) + boff + n * 2048 + k * 1024); } while (0)
#define PG8_MMA(ai, bj, At, Bt) do { __builtin_amdgcn_s_setprio(1); _Pragma("unroll") for (int m = 0; m < 4; ++m) _Pragma("unroll") for (int n = 0; n < 2; ++n) _Pragma("unroll") for (int k = 0; k < 2; ++k) \
        acc[ai][bj][m][n] = __builtin_amdgcn_mfma_f32_16x16x32_bf16(Bt[n][k], At[m][k], acc[ai][bj][m][n], 0, 0, 0); __builtin_amdgcn_s_setprio(0); } while (0)
#define PG8_WAIT_V(n) asm volatile("s_waitcnt vmcnt(" #n ")" ::: "memory")
#define PG8_WAIT_L(n) asm volatile("s_waitcnt lgkmcnt(" #n ")" ::: "memory")
#define PG8_BAR __builtin_amdgcn_s_barrier()
#define PG8_SCHED __builtin_amdgcn_sched_barrier(0)
    Unit cur, nxt; int ui = 0;
    if (!S.next(0, cur)) return;
    f32x4 acc[2][2][4][2];
#pragma unroll
    for (int a = 0; a < 2; ++a)
#pragma unroll
        for (int b = 0; b < 2; ++b)
#pragma unroll
            for (int m = 0; m < 4; ++m)
#pragma unroll
                for (int n = 0; n < 2; ++n) acc[a][b][m][n] = (f32x4){0.f, 0.f, 0.f, 0.f};
    bf16x8 At[4][2], B0[2][2], B1[2][2];
    const char* cA = (const char*)g.A + (size_t)cur.pm * tstep; const char* cB = (const char*)g.Bt + (size_t)cur.pn * tstep;
    S.a_ready(cur);
    if constexpr (SP2) {
        PG8_STAGE(PG8_SB(0, 0), cB, voffB); PG8_STAGE(PG8_SB(0, 1), cB + hstep, voffB); PG8_STAGE(PG8_SA(0, 0), cA, voffA); PG8_STAGE(PG8_SA(0, 1), cA + hstep, voffA);
        if (wr == 1) PG8_BAR;
        PG8_WAIT_V(2); PG8_BAR;
        PG8_STAGE(PG8_SB(1, 0), cB + kstep, voffB); PG8_STAGE(PG8_SA(1, 0), cA + kstep, voffA); PG8_STAGE(PG8_SB(1, 1), cB + hstep + kstep, voffB);
        PG8_WAIT_V(6); PG8_BAR;
    } else {
        PG8_STAGE(PG8_SB(0, 0), cB, voffB); PG8_STAGE(PG8_SA(0, 0), cA, voffA); PG8_STAGE(PG8_SB(0, 1), cB + hstep, voffB); PG8_STAGE(PG8_SA(0, 1), cA + hstep, voffA);
        if (wr == 1) PG8_BAR;
        PG8_WAIT_V(4); PG8_BAR;
        PG8_STAGE(PG8_SB(1, 0), cB + kstep, voffB); PG8_STAGE(PG8_SA(1, 0), cA + kstep, voffA); PG8_STAGE(PG8_SB(1, 1), cB + hstep + kstep, voffB);
        PG8_WAIT_V(6); PG8_BAR;
    }
    for (;;) {
        const bool has_next = S.next(ui + 1, nxt);
        const char* nA = has_next ? (const char*)g.A + (size_t)nxt.pm * tstep : cA; const char* nB = has_next ? (const char*)g.Bt + (size_t)nxt.pn * tstep : cB;
        for (int t = 0; t < nt; t += 2) {
            const bool last = (t == nt - 2);
            const char* a1 = cA + (size_t)(t + 1) * kstep;
            const char* a2 = last ? nA : cA + (size_t)(t + 2) * kstep; const char* b2 = last ? nB : cB + (size_t)(t + 2) * kstep;
            const char* a3 = a2 + kstep; const char* b3 = b2 + kstep;
            if (last && has_next) S.a_ready(nxt);
            if constexpr (SP2) {
            PG8_LDB(B0, 0, 0); PG8_LDB(B1, 0, 1); PG8_SCHED; PG8_LDA(At, 0, 0); PG8_STAGE(PG8_SA(1, 1), a1 + hstep, voffA);
            PG8_WAIT_V(8); PG8_WAIT_L(0); PG8_BAR; PG8_MMA(0, 0, At, B0); PG8_MMA(0, 1, At, B1); PG8_BAR; PG8_SCHED;
            PG8_LDA(At, 0, 1); PG8_STAGE(PG8_SB(0, 0), b2, voffB); PG8_STAGE(PG8_SB(0, 1), b2 + hstep, voffB); PG8_STAGE(PG8_SA(0, 0), a2, voffA);
            PG8_WAIT_V(8); PG8_WAIT_L(0); PG8_BAR; PG8_MMA(1, 0, At, B0); PG8_MMA(1, 1, At, B1); PG8_BAR; PG8_SCHED;
            PG8_LDB(B0, 1, 0); PG8_LDB(B1, 1, 1); PG8_SCHED; PG8_LDA(At, 1, 0); PG8_STAGE(PG8_SA(0, 1), a2 + hstep, voffA);
            PG8_WAIT_V(8); PG8_WAIT_L(0); PG8_BAR; PG8_MMA(0, 0, At, B0); PG8_MMA(0, 1, At, B1); PG8_BAR; PG8_SCHED;
            PG8_LDA(At, 1, 1); PG8_STAGE(PG8_SB(1, 0), b3, voffB); PG8_STAGE(PG8_SB(1, 1), b3 + hstep, voffB); PG8_STAGE(PG8_SA(1, 0), a3, voffA);
            PG8_WAIT_V(8); PG8_WAIT_L(0); PG8_BAR; PG8_MMA(1, 0, At, B0); PG8_MMA(1, 1, At, B1); PG8_BAR; PG8_SCHED;
            } else {
            PG8_LDB(B0, 0, 0); PG8_SCHED; PG8_LDA(At, 0, 0); PG8_STAGE(PG8_SA(1, 1), a1 + hstep, voffA);
            PG8_WAIT_L(8); PG8_BAR; PG8_WAIT_L(0); PG8_MMA(0, 0, At, B0); PG8_BAR; PG8_SCHED;
            PG8_LDB(B1, 0, 1); PG8_STAGE(PG8_SB(0, 0), b2, voffB);
            PG8_BAR; PG8_WAIT_L(0); PG8_MMA(0, 1, At, B1); PG8_BAR;
            PG8_LDA(At, 0, 1); PG8_STAGE(PG8_SA(0, 0), a2, voffA);
            PG8_BAR; PG8_WAIT_L(0); PG8_MMA(1, 0, At, B0); PG8_BAR; PG8_SCHED;
            PG8_STAGE(PG8_SB(0, 1), b2 + hstep, voffB);
            PG8_WAIT_V(6); PG8_BAR; PG8_MMA(1, 1, At, B1); PG8_BAR;
            PG8_LDB(B0, 1, 0); PG8_SCHED; PG8_LDA(At, 1, 0); PG8_STAGE(PG8_SA(0, 1), a2 + hstep, voffA);
            PG8_WAIT_L(8); PG8_BAR; PG8_WAIT_L(0); PG8_MMA(0, 0, At, B0); PG8_BAR; PG8_SCHED;
            PG8_LDB(B1, 1, 1); PG8_STAGE(PG8_SB(1, 0), b3, voffB);
            PG8_BAR; PG8_WAIT_L(0); PG8_MMA(0, 1, At, B1); PG8_BAR;
            PG8_LDA(At, 1, 1); PG8_STAGE(PG8_SA(1, 0), a3, voffA);
            PG8_BAR; PG8_WAIT_L(0); PG8_MMA(1, 0, At, B0); PG8_BAR; PG8_SCHED;
            PG8_STAGE(PG8_SB(1, 1), b3 + hstep, voffB);
            PG8_WAIT_V(6); PG8_BAR; PG8_MMA(1, 1, At, B1); PG8_BAR;
            }
        }
        if constexpr (ALIGN_EPI) { if (wr == 0) PG8_BAR; }
        if constexpr (!Epi::AFTER_DRAIN) { E(acc, cur, wr, wc, fr, fq); S.done(cur); }
        if (!has_next) break;
#pragma unroll
        for (int a = 0; a < 2; ++a)
#pragma unroll
            for (int b = 0; b < 2; ++b)
#pragma unroll
                for (int m = 0; m < 4; ++m)
#pragma unroll
                    for (int n = 0; n < 2; ++n) acc[a][b][m][n] = (f32x4){0.f, 0.f, 0.f, 0.f};
        cur = nxt; cA = nA; cB = nB; ++ui;
        if constexpr (ALIGN_EPI) { if (wr == 1) PG8_BAR; }
    }
    PG8_WAIT_V(0);
    if constexpr (!ALIGN_EPI) { if (wr == 0) PG8_BAR; }
    PG8_BAR;
    if constexpr (Epi::AFTER_DRAIN) { E.fused(acc, cur, wr, wc, fr, fq, lds, wid, lane); S.done(cur); }
#undef PG8_SA
#undef PG8_SB
#undef PG8_STAGE
#undef PG8_LDA
#undef PG8_LDB
#undef PG8_MMA
#undef PG8_WAIT_V
#undef PG8_WAIT_L
#undef PG8_BAR
#undef PG8_SCHED
}
}
#define GAS __attribute__((address_space(1)))
#define LAS __attribute__((address_space(3)))
typedef unsigned short bf16;
typedef unsigned v4u __attribute__((ext_vector_type(4)));
typedef float f32x4 __attribute__((ext_vector_type(4)));
typedef short bf16x8 __attribute__((ext_vector_type(8)));
typedef GAS unsigned gu32;
typedef GAS unsigned long long gu64;
#define RLX_AGENT __ATOMIC_RELAXED, __HIP_MEMORY_SCOPE_AGENT
#define LDS_WAIT() asm volatile("s_waitcnt lgkmcnt(0)" ::: "memory")
#define VM_WAIT() asm volatile("s_waitcnt vmcnt(0)" ::: "memory")
__device__ __forceinline__ unsigned long long rt() { return __builtin_amdgcn_s_memrealtime(); }
__device__ __forceinline__ unsigned f2bf(float f) { unsigned u = __builtin_bit_cast(unsigned, f); return (u + 0x7fffu + ((u >> 16) & 1u)) >> 16; }
__device__ __forceinline__ unsigned pk2(float lo, float hi) { return f2bf(lo) | (f2bf(hi) << 16); }

#define XB_TMO      128
#define XB_XCNT(j)  (256  + 64 * (j))
#define XB_XSUB(j)  (1280 + 64 * (j))
#define XB_XGEN(j)  (2304 + 64 * (j))
#define XB_TOP      3328
#define XB_TOPGEN   3392
#define XCD_BAR_WORDS 3456
#define XB_SPIN_CAP (1u << 22)

__device__ __forceinline__ unsigned xb_ld(unsigned* p)              { return __hip_atomic_load(p, __ATOMIC_RELAXED, __HIP_MEMORY_SCOPE_AGENT); }
__device__ __forceinline__ unsigned xb_add(unsigned* p, unsigned v) { return __hip_atomic_fetch_add(p, v, __ATOMIC_RELAXED, __HIP_MEMORY_SCOPE_AGENT); }
__device__ __forceinline__ unsigned xb_xcc_id() { return (unsigned)__builtin_amdgcn_s_getreg((3 << 11) | 20) & 0xFu; }
#define XB_SPIN(cond, bar) do { unsigned _sp = 0; while (cond) { __builtin_amdgcn_s_sleep(1); \
    if ((++_sp & 255u) == 0u) { if (xb_ld(&(bar)[XB_TMO])) break; if (_sp > XB_SPIN_CAP) { atomicAdd(&(bar)[XB_TMO], 1u); break; } } } } while (0)

struct XcdBarrier {
    unsigned* bar; unsigned x;
    volatile LAS unsigned* st;
};

__device__ __forceinline__ XcdBarrier xcd_barrier_post(unsigned* bar, volatile LAS unsigned* st) {
    XcdBarrier b; b.bar = bar; b.x = xb_xcc_id(); b.st = st;
    if (threadIdx.x == 0) (void)xb_add(&bar[XB_XCNT(b.x)], 1u);
    return b;
}
__device__ __forceinline__ void xcd_barrier_complete(unsigned* bar, unsigned x, unsigned& nloc, unsigned& nx) {
    const unsigned G = gridDim.x * gridDim.y * gridDim.z;
    unsigned sum, cnt, mine, sp = 0u;
    for (;;) {
        sum = 0u; cnt = 0u; mine = 0u;
#pragma unroll
        for (unsigned j = 0; j < 16; ++j) { const unsigned c = xb_ld(&bar[XB_XCNT(j)]); sum += c; cnt += (c > 0u) ? 1u : 0u; mine = (j == x) ? c : mine; }
        if (sum == G) break;
        __builtin_amdgcn_s_sleep(1);
        if ((++sp & 255u) == 0u) { if (xb_ld(&bar[XB_TMO])) break; if (sp > XB_SPIN_CAP) { atomicAdd(&bar[XB_TMO], 1u); break; } }
    }
    nloc = mine > 0u ? mine : 1u; nx = cnt > 0u ? cnt : 1u;
}

__device__ __forceinline__ void xcd_barrier(const XcdBarrier& b) {
    asm volatile("s_waitcnt vmcnt(0)" ::: "memory");
    __syncthreads();
    if (threadIdx.x == 0) {
        unsigned* bar = b.bar;
        __builtin_amdgcn_s_waitcnt(0);
        unsigned nloc = b.st[0], nx = b.st[1];
        if (nloc == 0u) { xcd_barrier_complete(bar, b.x, nloc, nx); b.st[0] = nloc; b.st[1] = nx; }
        const unsigned old = xb_add(&bar[XB_XSUB(b.x)], 1u);
        const unsigned gen = old / nloc;
        if (old + 1u == (gen + 1u) * nloc) {
            __builtin_amdgcn_fence(__ATOMIC_RELEASE, "agent");
            asm volatile("s_waitcnt vmcnt(0)" ::: "memory");
            const unsigned og = xb_add(&bar[XB_TOP], 1u);
            const unsigned tg = og / nx;
            if (og + 1u == (tg + 1u) * nx) xb_add(&bar[XB_TOPGEN], 1u);
            else XB_SPIN(xb_ld(&bar[XB_TOPGEN]) == tg, bar);
            __builtin_amdgcn_fence(__ATOMIC_ACQUIRE, "agent");
            xb_add(&bar[XB_XGEN(b.x)], 1u);
            asm volatile("s_waitcnt vmcnt(0)" ::: "memory");
        } else {
            XB_SPIN(xb_ld(&bar[XB_XGEN(b.x)]) == gen, bar);
            __builtin_amdgcn_fence(__ATOMIC_ACQUIRE, "agent");
            asm volatile("s_waitcnt vmcnt(0)" ::: "memory");
        }
    }
    __syncthreads();
}
namespace att {
typedef unsigned short abf;
typedef short bf16x8 __attribute__((ext_vector_type(8)));
typedef short s16x4 __attribute__((ext_vector_type(4)));
typedef float f32x16 __attribute__((ext_vector_type(16)));
typedef float f32x4 __attribute__((ext_vector_type(4)));
typedef unsigned u32x4 __attribute__((ext_vector_type(4)));
constexpr float SCALE = 0.08838834764831845f;
constexpr float THR = 8.f;
constexpr int D = 128, NW = 8, QBLK = 32, KVBLK = 64, QB = NW * QBLK;
constexpr int KVP = 5888, OP = 2048;
constexpr int SHM_V = KVBLK * D * 2, SHM_K = KVBLK * D * 2;
constexpr int ATT_LDS_BYTES = 2 * SHM_V + 2 * SHM_K + NW * 64 * 4;

#define KSWZ(row, colB) ((row) * 256 + ((colB) ^ (((row) & 7) << 4)))
#define SBAR() __builtin_amdgcn_sched_barrier(0)
__device__ __forceinline__ int v_st(int k, int c) { const int kk = (k & ~0xC) | ((k & 4) << 1) | ((k & 8) >> 1); return ((kk >> 3) * 4 + (c >> 5)) * 512 + ((kk & 7) * 32 + (c & 31)) * 2; }
__device__ __forceinline__ int v_rd_base(int lane) { return ((lane & 3) << 3) | (((lane >> 2) & 3) << 6) | (((lane >> 4) & 1) << 5) | (((lane >> 5) & 1) << 8); }
constexpr int v_rd_off(int d0, int ks, int half) { return d0 * 512 + ks * 4096 + half * 2048; }
__device__ __forceinline__ int crow(int r, int hi) { return (r & 3) + 8 * (r >> 2) + 4 * hi; }
__device__ __forceinline__ unsigned cvtpk(float lo, float hi) { unsigned r; asm volatile("v_cvt_pk_bf16_f32 %0, %1, %2" : "=v"(r) : "v"(lo), "v"(hi)); return r; }
__device__ __forceinline__ bf16x8 load8(const abf* p) { return *reinterpret_cast<const bf16x8*>(p); }
__device__ __forceinline__ void mask_tile(f32x16& p0, f32x16& p1, int dq) {
    const float NEG = -__builtin_inff();
#pragma unroll
    for (int r = 0; r < 16; ++r) {
        const int c = (r & 3) + 8 * (r >> 2);
        if (dq - c < 0) p0[r] = NEG;
        if (dq - c - 32 < 0) p1[r] = NEG;
    }
}
__device__ __forceinline__ void kill_tile(f32x16& p0, f32x16& p1, bool keep) {
    const float NEG = -__builtin_inff();
#pragma unroll
    for (int r = 0; r < 16; ++r) { p0[r] = keep ? p0[r] : NEG; p1[r] = keep ? p1[r] : NEG; }
}
__device__ __forceinline__ void partialSM(f32x16& p0, f32x16& p1, float& m_reg, float& mn, float& alpha) {
    float pmax = p0[0]; for (int r = 1; r < 16; ++r) pmax = fmaxf(pmax, p0[r]); for (int r = 0; r < 16; ++r) pmax = fmaxf(pmax, p1[r]);
    { auto rr = __builtin_amdgcn_permlane32_swap(__float_as_uint(pmax), __float_as_uint(pmax), false, false);
      pmax = fmaxf(__uint_as_float(rr[0]), __uint_as_float(rr[1])); }
    constexpr float C2 = 1.4426950408889634f * SCALE;
    if (__builtin_expect(__all((pmax - m_reg) * SCALE <= THR), 1)) { mn = m_reg; alpha = 1.f; }
    else { mn = fmaxf(m_reg, pmax); alpha = __builtin_amdgcn_exp2f((m_reg - mn) * C2); m_reg = mn; }
    const float mnL = -mn * C2;
    for (int r = 0; r < 16; ++r) p0[r] = fmaf(p0[r], C2, mnL); for (int r = 0; r < 16; ++r) p1[r] = fmaf(p1[r], C2, mnL);
    for (int r = 0; r < 16; ++r) p0[r] = __builtin_amdgcn_exp2f(p0[r]);
}
__device__ __forceinline__ void finishSM(f32x16& p0, f32x16& p1, float alpha, float& l_reg, bf16x8& pa0, bf16x8& pa1, bf16x8& pa2, bf16x8& pa3) {
    for (int r = 0; r < 16; ++r) p1[r] = __builtin_amdgcn_exp2f(p1[r]);
    float ps = 0; for (int r = 0; r < 16; ++r) ps += p0[r]; for (int r = 0; r < 16; ++r) ps += p1[r];
    { auto rr = __builtin_amdgcn_permlane32_swap(__float_as_uint(ps), __float_as_uint(ps), false, false);
      ps = __uint_as_float(rr[0]) + __uint_as_float(rr[1]); }
    l_reg = l_reg * alpha + ps;
#define PK4(P, B_, OUT) do { unsigned a0 = cvtpk(P[B_+0], P[B_+1]), a1 = cvtpk(P[B_+2], P[B_+3]);                          \
        unsigned b0 = cvtpk(P[B_+4], P[B_+5]), b1 = cvtpk(P[B_+6], P[B_+7]);                                             \
        auto r0 = __builtin_amdgcn_permlane32_swap(a0, b0, false, false); auto r1 = __builtin_amdgcn_permlane32_swap(a1, b1, false, false); \
        u32x4 w = {r0[0], r1[0], r0[1], r1[1]}; OUT = *reinterpret_cast<bf16x8*>(&w); } while (0)
    PK4(p0, 0, pa0); PK4(p0, 8, pa1); PK4(p1, 0, pa2); PK4(p1, 8, pa3);
#undef PK4
}
template <int KB>
__device__ __forceinline__ void qkt(f32x16& p0, f32x16& p1, const char* K_lds, int r32, int hi, const bf16x8* qr) {
    p0 = f32x16{}; p1 = f32x16{};
    const char* kb[4];
#pragma unroll
    for (int dd = 0; dd < 4; ++dd) kb[dd] = K_lds + KB * SHM_K + KSWZ(r32, (dd * 16 + hi * 8) * 2);
#pragma unroll
    for (int d0 = 0; d0 < 8; ++d0) { const char* a = kb[d0 & 3] + (d0 >> 2) * 128;
        bf16x8 b0 = *reinterpret_cast<const bf16x8*>(a);
        bf16x8 b1 = *reinterpret_cast<const bf16x8*>(a + 32 * 256);
        p0 = __builtin_amdgcn_mfma_f32_32x32x16_bf16(b0, qr[d0], p0, 0, 0, 0);
        p1 = __builtin_amdgcn_mfma_f32_32x32x16_bf16(b1, qr[d0], p1, 0, 0, 0); }
}
template <int VB>
__device__ __forceinline__ void pv_tile(f32x16* o, int vb0, bf16x8 pa0, bf16x8 pa1, bf16x8 pa2, bf16x8 pa3) {
#define TRRD(dst, off) asm volatile("ds_read_b64_tr_b16 %0, %1 offset:%2" : "=&v"(dst) : "v"(vb0), "i"(off) : "memory")
#define PV_D0(d0) do { s16x4 l0, l1, l2, l3, h0, h1, h2, h3; constexpr int b_ = VB * SHM_V + v_rd_off(d0, 0, 0);     \
        TRRD(l0, b_); TRRD(h0, b_ + 2048); TRRD(l1, b_ + 4096); TRRD(h1, b_ + 6144); TRRD(l2, b_ + 8192); TRRD(h2, b_ + 10240); TRRD(l3, b_ + 12288); TRRD(h3, b_ + 14336); \
        asm volatile("s_waitcnt lgkmcnt(0)" ::: "memory"); SBAR();                 \
        o[d0] = __builtin_amdgcn_mfma_f32_32x32x16_bf16(pa0, (bf16x8){l0[0], l0[1], l0[2], l0[3], h0[0], h0[1], h0[2], h0[3]}, o[d0], 0, 0, 0);   \
        o[d0] = __builtin_amdgcn_mfma_f32_32x32x16_bf16(pa1, (bf16x8){l1[0], l1[1], l1[2], l1[3], h1[0], h1[1], h1[2], h1[3]}, o[d0], 0, 0, 0);   \
        o[d0] = __builtin_amdgcn_mfma_f32_32x32x16_bf16(pa2, (bf16x8){l2[0], l2[1], l2[2], l2[3], h2[0], h2[1], h2[2], h2[3]}, o[d0], 0, 0, 0);   \
        o[d0] = __builtin_amdgcn_mfma_f32_32x32x16_bf16(pa3, (bf16x8){l3[0], l3[1], l3[2], l3[3], h3[0], h3[1], h3[2], h3[3]}, o[d0], 0, 0, 0); } while (0)
    PV_D0(0); PV_D0(1); PV_D0(2); PV_D0(3);
#undef PV_D0
#undef TRRD
}

struct BlockRef { const abf* Q; const abf* K; const abf* V; abf* O; const float* kmean; int P0; };
struct Seam { bf16x8 qr[8]; bf16x8 st_v0, st_v1, st_k0, st_k1; };
#define ROW(p, k0, rr) ((p) + (size_t)((k0) + (rr)) * KVP + sc)
#define VMW() asm volatile("s_waitcnt vmcnt(0)" ::: "memory")
#define VMWN(n) asm volatile("s_waitcnt vmcnt(%0)" :: "i"(n) : "memory")
#define SLOAD_H(Kp, Vp, k0) do { S.st_v0 = load8(ROW(Vp, k0, sr)); S.st_v1 = load8(ROW(Vp, k0, 32 + sr));              \
                         S.st_k0 = load8(ROW(Kp, k0, sr)); S.st_k1 = load8(ROW(Kp, k0, 32 + sr)); } while (0)
#define SWRITE_HK(bf) do { *(bf16x8*)(K_lds + (bf) * SHM_K + kws) = S.st_k0; *(bf16x8*)(K_lds + (bf) * SHM_K + kws + 32 * 256) = S.st_k1; } while (0)
#define SWRITE_HV(bf) do { *(bf16x8*)(V_lds + (bf) * SHM_V + vst0) = S.st_v0; *(bf16x8*)(V_lds + (bf) * SHM_V + vst1) = S.st_v1; } while (0)
#define SWRITE_H(bf) do { SWRITE_HV(bf); SWRITE_HK(bf); } while (0)
__device__ __forceinline__ void moba_prime(const BlockRef& cur, char* lds, Seam& S, int tid) {
    const int wid = __builtin_amdgcn_readfirstlane(tid >> 6), lane = tid & 63, r32 = lane & 31, hi = lane >> 5;
    const int sr = tid >> 4, sc = (tid & 15) * 8, kws = KSWZ(sr, sc * 2); char* K_lds = lds + 2 * SHM_V;
#pragma unroll
    for (int d0 = 0; d0 < 8; ++d0) S.qr[d0] = load8(cur.Q + (size_t)(wid * QBLK + r32) * KVP + d0 * 16 + hi * 8);
    SLOAD_H(cur.K, cur.V, 0); VMW(); SWRITE_HK(0);
    __syncthreads();
}
__device__ __forceinline__ void moba_block(const BlockRef& cur, const BlockRef& nxt, char* lds, Seam& S, int tid) {
    const int wid = __builtin_amdgcn_readfirstlane(tid >> 6), lane = tid & 63, r32 = lane & 31, hi = lane >> 5;
    const int qb = cur.P0 >> 8;
    const int NT = (cur.P0 + QB) / KVBLK;
    const int qlo = cur.P0 + wid * QBLK, qm = qlo + r32 - 4 * hi;
    char* V_lds = lds; char* K_lds = lds + 2 * SHM_V;
    float* wsl = (float*)(lds + 2 * SHM_V + 2 * SHM_K) + wid * 64; float* li_l = wsl, * al_l = wsl + 32;
    unsigned sel = (1u << qb) - 1u;
    if (qb > 3) {
        float gate[7];
#pragma unroll
        for (int n = 0; n < 7; ++n) { float g = 0.f;
            if (n < qb) {
#pragma unroll
                for (int d0 = 0; d0 < 8; ++d0) { const float* km = cur.kmean + n * 128 + d0 * 16 + hi * 8; const f32x4 k0 = *(const f32x4*)km, k1 = *(const f32x4*)(km + 4); const bf16x8 q = S.qr[d0];
                    g += __uint_as_float((unsigned)(unsigned short)q[0] << 16) * k0[0] + __uint_as_float((unsigned)(unsigned short)q[1] << 16) * k0[1] + __uint_as_float((unsigned)(unsigned short)q[2] << 16) * k0[2] + __uint_as_float((unsigned)(unsigned short)q[3] << 16) * k0[3];
                    g += __uint_as_float((unsigned)(unsigned short)q[4] << 16) * k1[0] + __uint_as_float((unsigned)(unsigned short)q[5] << 16) * k1[1] + __uint_as_float((unsigned)(unsigned short)q[6] << 16) * k1[2] + __uint_as_float((unsigned)(unsigned short)q[7] << 16) * k1[3]; } }
            gate[n] = g + __shfl_xor(g, 32); }
        sel = 0u;
#pragma unroll
        for (int pick = 0; pick < 3; ++pick) { float best = -__builtin_inff(); int bi = -1;
#pragma unroll
            for (int n = 0; n < 7; ++n) { const bool ok = (n < qb) && !((sel >> n) & 1u) && (gate[n] > best); if (ok) { best = gate[n]; bi = n; } }
            if (bi >= 0) sel |= 1u << bi; }
    }
    float m_reg = -1e30f, l_reg = 0; f32x16 o[4] = {};
    const int sr = tid >> 4, sc = (tid & 15) * 8, vst0 = v_st(sr, sc), vst1 = v_st(32 + sr, sc), kws = KSWZ(sr, sc * 2);
    const int vb0 = (int)(uintptr_t)V_lds + v_rd_base(lane);
    const abf* Kh = cur.K; const abf* Vh = cur.V;
#define RESC(a) do { if (__any((a) < 1.f)) { if (hi == 0) al_l[r32] = (a); asm volatile("s_waitcnt lgkmcnt(0)" ::: "memory");              \
                     for (int d_ = 0; d_ < 4; ++d_) for (int r = 0; r < 16; ++r) o[d_][r] *= al_l[crow(r, hi)]; } } while (0)
#define KBASE(t) ((t) * KVBLK)
#define MASKT(P0_, P1_, t) do { const int kb_ = KBASE(t); const int nb_ = kb_ >> 8; \
        if (nb_ < qb) { const bool keep_ = (sel >> nb_) & 1u; if (!__all(keep_)) kill_tile(P0_, P1_, keep_); } \
        else if (kb_ + KVBLK - 1 > qlo) mask_tile(P0_, P1_, qm - kb_); } while (0)
    constexpr int NQL = 8;
#define SEAM_K0() do { VMWN(NQL); SWRITE_HK(0); SBAR(); } while (0)
    f32x16 pA0, pA1, pB0, pB1; float mnA, mnB, alA, alB; bf16x8 pa0, pa1, pa2, pa3;
    SWRITE_HV(0); SBAR();
    if (NT > 1) { SLOAD_H(Kh, Vh, KBASE(1)); }
    SBAR(); qkt<0>(pA0, pA1, K_lds, r32, hi, S.qr);
    MASKT(pA0, pA1, 0); partialSM(pA0, pA1, m_reg, mnA, alA);
    if (NT > 1) { VMW(); SWRITE_H(1); }
    __syncthreads();
#define HALF_STEP(PX0, PX1, mnX, alX, PY0, PY1, alY, t, KB, VB, SB) do {                                                      \
        SBAR(); qkt<KB>(PX0, PX1, K_lds, r32, hi, S.qr);                                                                       \
        finishSM(PY0, PY1, alY, l_reg, pa0, pa1, pa2, pa3); SBAR();                                                           \
        if ((t) + 1 < NT) { SLOAD_H(Kh, Vh, KBASE((t) + 1)); SBAR(); }                                                        \
        pv_tile<VB>(o, vb0, pa0, pa1, pa2, pa3); MASKT(PX0, PX1, (t)); partialSM(PX0, PX1, m_reg, mnX, alX);                   \
        __syncthreads();                                                                                                      \
        if ((t) + 1 < NT) { VMW(); SWRITE_H(SB); }                                                                            \
        RESC(alX); __syncthreads(); } while (0)
    for (int t = 1; t + 1 < NT; t += 2) {
        HALF_STEP(pB0, pB1, mnB, alB, pA0, pA1, alA, t, 1, 0, 0);
        HALF_STEP(pA0, pA1, mnA, alA, pB0, pB1, alB, t + 1, 0, 1, 1);
    }
    const bool even = (NT & 1) == 0;
    if (even) { SBAR(); qkt<1>(pB0, pB1, K_lds, r32, hi, S.qr); SBAR(); }
    SLOAD_H(nxt.K, nxt.V, 0); SBAR();
#pragma unroll
    for (int d0 = 0; d0 < 8; ++d0) S.qr[d0] = load8(nxt.Q + (size_t)(wid * QBLK + r32) * KVP + d0 * 16 + hi * 8);
    SBAR();
    finishSM(pA0, pA1, alA, l_reg, pa0, pa1, pa2, pa3); SBAR();
    pv_tile<0>(o, vb0, pa0, pa1, pa2, pa3);
    if (even) { MASKT(pB0, pB1, NT - 1); partialSM(pB0, pB1, m_reg, mnB, alB); __syncthreads(); RESC(alB);
        finishSM(pB0, pB1, alB, l_reg, pa0, pa1, pa2, pa3); SBAR(); pv_tile<1>(o, vb0, pa0, pa1, pa2, pa3); }
    SBAR(); SEAM_K0();
    if (hi == 0) li_l[r32] = l_reg; asm volatile("s_waitcnt lgkmcnt(0)" ::: "memory");
    float rli[16];
#pragma unroll
    for (int r = 0; r < 16; ++r) rli[r] = __builtin_amdgcn_rcpf(li_l[crow(r, hi)]);
    abf* Ow = cur.O + (size_t)(wid * QBLK) * OP;
#pragma unroll
    for (int r = 0; r < 16; ++r) { const int orow = crow(r, hi);
#pragma unroll
        for (int d0 = 0; d0 < 4; ++d0) { const float v = o[d0][r] * rli[r];
            const float vn = __shfl_xor(v, 1);
            if ((r32 & 1) == 0) *(unsigned*)(Ow + (size_t)orow * OP + d0 * 32 + r32) = cvtpk(v, vn); } }
    __syncthreads();
#undef RESC
#undef KBASE
#undef MASKT
#undef SEAM_K0
#undef HALF_STEP
}
#undef ROW
#undef VMW
#undef VMWN
#undef SLOAD_H
#undef SWRITE_HK
#undef SWRITE_HV
#undef SWRITE_H
#undef KSWZ
#undef SBAR
}


constexpr int NWAVES = 8;
constexpr int BATCH = 4, SEQ = 2048, DM = 2048, MTOK = BATCH * SEQ, DEPTH = 4;
constexpr int AW = 1024, NH = 8, HD = 128, MOBA_BLK = 256, NBLK = SEQ / MOBA_BLK;
constexpr int SW = 1024, SH = 16, SP = 64, SN = 128, CONVD = 1536;
constexpr int IN_DIM = 5648, NPROJ = 5888, DFF = 8192;
constexpr int CQ = 0, CK = 1024, CV = 2048, CZ = 3072, CX = 4096, CBm = 5120, CCm = 5376, CDT = 5632;
constexpr float NORM_EPS = 1e-6f;
constexpr float ATT_SCALE = 0.08838834764831845f;

constexpr size_t MiB = 1u << 20;
constexpr size_t WS_CTL = 0, CTL_ZERO_BYTES = 1 * MiB;
constexpr size_t WS_ROPE = 1 * MiB;
constexpr size_t WS_INVA = 2 * MiB, WS_INVB = 2 * MiB + 64 * 1024;
constexpr size_t WS_KMEAN = 2 * MiB + 128 * 1024;
constexpr size_t WS_DT = 3 * MiB;
constexpr size_t WS_WIN = 4 * MiB, WIN_BYTES = (size_t)NPROJ * DM * 2;
constexpr size_t WS_WOUT = 96 * MiB, WOUT_BYTES = (size_t)DM * DM * 2;
constexpr size_t WS_WUP = 128 * MiB, WUP_BYTES = (size_t)DFF * DM * 2;
constexpr size_t WS_WDN = 256 * MiB, WDN_BYTES = (size_t)DM * DFF * 2;
constexpr size_t WS_XB = 384 * MiB;
constexpr size_t WS_PROJ = 416 * MiB;
constexpr size_t WS_MIX = 508 * MiB;
constexpr size_t WS_Y = 540 * MiB;
constexpr size_t WS_HID = 604 * MiB;
constexpr size_t WS_XBC = 732 * MiB;
constexpr size_t WS_YS = 780 * MiB;
constexpr size_t WS_END = 812 * MiB;
static_assert(WS_WIN + 4 * WIN_BYTES <= WS_WOUT && WS_PROJ + (size_t)MTOK * NPROJ * 2 <= WS_MIX, "ws map");
constexpr int CW_BAR = 4096;

constexpr int RING_BYTES = 131072, LDSCTL_OFF = RING_BYTES, MISC_OFF = LDSCTL_OFF + 320, LDS_BYTES = 147456;

typedef unsigned long long u64;
__device__ __forceinline__ float bf2f(bf16 b) { return __uint_as_float(((unsigned)b) << 16); }
__device__ __forceinline__ float wave_sum(float v) {
#pragma unroll
    for (int o = 1; o < 64; o <<= 1) v += __shfl_xor(v, o);
    return v;
}
__device__ __forceinline__ float wave_max(float v) {
#pragma unroll
    for (int o = 1; o < 64; o <<= 1) v = fmaxf(v, __shfl_xor(v, o));
    return v;
}
__device__ __forceinline__ float silu_f(float v) { return v / (1.f + __expf(-v)); }
__device__ __forceinline__ float softplus_f(float v) { return fmaxf(v, 0.f) + log1pf(__expf(-fabsf(v))); }

__device__ __forceinline__ void transpose_item(const float* W, int ldw, int ncols, int K, const float* gain, bf16* WT, LAS float* scr, int item, int lane) {
    const int nblk = ncols / 32, kb = item / nblk, nb = item % nblk, k0 = 64 * kb, n0 = 32 * nb;
#pragma unroll 8
    for (int i = 0; i < 32; ++i) { const int kk = 2 * i + (lane >> 5); float v = W[(size_t)(k0 + kk) * ldw + n0 + (lane & 31)]; if (gain) v *= gain[k0 + kk]; scr[kk * 33 + (lane & 31)] = v; }
    LDS_WAIT(); asm volatile("" ::: "memory");
    const int c = lane & 7;
#pragma unroll
    for (int j = 0; j < 4; ++j) { const int n = (lane >> 3) + 8 * j; const LAS float* s = scr + (8 * c) * 33 + n;
        v4u o; o.x = pk2(s[0 * 33], s[1 * 33]); o.y = pk2(s[2 * 33], s[3 * 33]); o.z = pk2(s[4 * 33], s[5 * 33]); o.w = pk2(s[6 * 33], s[7 * 33]);
        *(GAS v4u*)(WT + (size_t)(n0 + n) * K + k0 + 8 * c) = o; }
    LDS_WAIT(); asm volatile("" ::: "memory");
}

__device__ __forceinline__ void row_update(const float* xrow, const float* yrow, const float* g, float* xo, bf16* xb, float* inv, int lane) {
    f32x4 v[8];
#pragma unroll
    for (int j = 0; j < 8; ++j) v[j] = ((const GAS f32x4*)xrow)[lane + 64 * j];
    if (yrow) {
        f32x4 y[8]; float s = 0.f;
#pragma unroll
        for (int j = 0; j < 8; ++j) { y[j] = ((const GAS f32x4*)yrow)[lane + 64 * j]; s += (y[j].x * y[j].x + y[j].y * y[j].y) + (y[j].z * y[j].z + y[j].w * y[j].w); }
        const float iy = 1.0f / sqrtf(wave_sum(s) * (1.f / DM) + NORM_EPS);
#pragma unroll
        for (int j = 0; j < 8; ++j) { const f32x4 gg = ((const GAS f32x4*)g)[lane + 64 * j]; v[j] = v[j] + (y[j] * iy) * gg; }
    }
    float s2 = 0.f;
#pragma unroll
    for (int j = 0; j < 8; ++j) { s2 += (v[j].x * v[j].x + v[j].y * v[j].y) + (v[j].z * v[j].z + v[j].w * v[j].w);
        ((GAS f32x4*)xo)[lane + 64 * j] = v[j];
        ((GAS u64*)xb)[lane + 64 * j] = (u64)pk2(v[j].x, v[j].y) | ((u64)pk2(v[j].z, v[j].w) << 32); }
    const float ix = 1.0f / sqrtf(wave_sum(s2) * (1.f / DM) + NORM_EPS);
    if (lane == 0) *inv = ix;
}

struct Args { const void* in[17]; float* out; unsigned char* ws; int ph_lo, ph_hi; };
constexpr int NPH_LAYER = 9, NPHASES = 1 + DEPTH * NPH_LAYER;

__global__ void __launch_bounds__(NWAVES * 64, 2) fwd_kernel(Args args) {
    extern __shared__ __attribute__((aligned(16))) unsigned char lds_raw[];
    LAS unsigned char* lds = (LAS unsigned char*)lds_raw;
    volatile LAS unsigned* MISC = (volatile LAS unsigned*)(lds + MISC_OFF);
    const int tid0 = threadIdx.x;
    const int G = gridDim.x, bx = blockIdx.x;
    const int NGW = G * NWAVES, NGT = G * NWAVES * 64;
#define PHASE_LOCALS int tid = tid0; asm volatile("" : "+v"(tid)); const int lane = tid & 63, wave = __builtin_amdgcn_readfirstlane(tid >> 6); \
    const int gw = bx * NWAVES + wave, gt = bx * (NWAVES * 64) + tid; (void)gw; (void)gt; (void)lane;
    unsigned char* ws = args.ws;
    gu32* ctl = (gu32*)(ws + WS_CTL);
    const float* x_in = (const float*)args.in[0]; const int* positions = (const int*)args.in[1];
    const float* pre_mix = (const float*)args.in[2]; const float* post_mix = (const float*)args.in[3];
    const float* pre_mlp = (const float*)args.in[4]; const float* post_mlp = (const float*)args.in[5];
    const float* w_in = (const float*)args.in[6]; const float* conv_w = (const float*)args.in[7]; const float* conv_b = (const float*)args.in[8];
    const float* dt_bias = (const float*)args.in[9]; const float* a_log = (const float*)args.in[10]; const float* d_skip = (const float*)args.in[11];
    const float* attn_norm = (const float*)args.in[12]; const float* ssd_norm = (const float*)args.in[13];
    const float* w_out = (const float*)args.in[14]; const float* w_up = (const float*)args.in[15]; const float* w_down = (const float*)args.in[16];
    float* xres = args.out;
    float2* ROPE = (float2*)(ws + WS_ROPE); float* INVA = (float*)(ws + WS_INVA); float* INVB = (float*)(ws + WS_INVB);
    float* KMEAN = (float*)(ws + WS_KMEAN); float* DTB = (float*)(ws + WS_DT);
    bf16* XB = (bf16*)(ws + WS_XB); bf16* PROJ = (bf16*)(ws + WS_PROJ); bf16* MIX = (bf16*)(ws + WS_MIX); float* Y = (float*)(ws + WS_Y);
    bf16* HID = (bf16*)(ws + WS_HID); float* XBC = (float*)(ws + WS_XBC); float* YS = (float*)(ws + WS_YS);

    for (int u = tid0; u < (LDS_BYTES - LDSCTL_OFF) / 4; u += NWAVES * 64) ((LAS unsigned*)(lds + LDSCTL_OFF))[u] = 0u;
    __syncthreads();
    const int lo = args.ph_lo, hi = args.ph_hi;
    XcdBarrier bar; bar.bar = (unsigned*)(ctl + CW_BAR); bar.x = 0; bar.st = nullptr;
    if (hi - lo > 1) bar = xcd_barrier_post((unsigned*)(ctl + CW_BAR), MISC + 8);
#ifndef PH_MASK
#define PH_MASK 0x3ff
#endif
#define PH_EN(j) ((PH_MASK >> (j)) & 1)
#define IN(k) (lo <= (k) && (k) < hi)
#define BOTH(k) (IN(k) && IN((k) + 1))
#define SEAM(k) do { if (BOTH(k)) xcd_barrier(bar); } while (0)

    if (PH_EN(9) && IN(0)) {
        PHASE_LOCALS
        LAS float* scr = (LAS float*)(lds + wave * 16384);
        constexpr int I_IN = (DM / 64) * (5632 / 32), I_OUT = (DM / 64) * (DM / 32), I_UP = (DM / 64) * (DFF / 32), I_DN = (DFF / 64) * (DM / 32), I_L = I_IN + I_OUT + I_UP + I_DN;
        for (int it = gw; it < DEPTH * I_L; it += NGW) {
            const int l = it / I_L; int r = it % I_L;
            if (r < I_IN) { transpose_item(w_in + (size_t)l * DM * IN_DIM, IN_DIM, 5632, DM, pre_mix + l * DM, (bf16*)(ws + WS_WIN + l * WIN_BYTES), scr, r, lane); continue; } r -= I_IN;
            if (r < I_OUT) { transpose_item(w_out + (size_t)l * DM * DM, DM, DM, DM, nullptr, (bf16*)(ws + WS_WOUT + l * WOUT_BYTES), scr, r, lane); continue; } r -= I_OUT;
            if (r < I_UP) { transpose_item(w_up + (size_t)l * DM * DFF, DFF, DFF, DM, pre_mlp + l * DM, (bf16*)(ws + WS_WUP + l * WUP_BYTES), scr, r, lane); continue; } r -= I_UP;
            transpose_item(w_down + (size_t)l * DFF * DM, DM, DM, DFF, nullptr, (bf16*)(ws + WS_WDN + l * WDN_BYTES), scr, r, lane);
        }
        for (int idx = gt; idx < DEPTH * 256 * DM; idx += NGT) { const int l = idx / (256 * DM), r = idx % (256 * DM), j = r / DM, k = r % DM;
            float v = 0.f; if (j < 16) v = w_in[((size_t)l * DM + k) * IN_DIM + 5632 + j] * pre_mix[l * DM + k];
            ((bf16*)(ws + WS_WIN + l * WIN_BYTES))[(size_t)(5632 + j) * DM + k] = (bf16)f2bf(v); }
        for (int idx = gt; idx < MTOK * 16; idx += NGT) { const int t = idx >> 4, i = idx & 15;
            const float invf = __builtin_amdgcn_exp2f(-(float)i * 1.1832230355827609f);
            const float angf = (float)positions[t] * invf; const double a = (double)angf;
            const double kq = rint(a * 0.63661977236758134); const double yv = fma(-kq, 1.5707963267948966, a) - kq * 6.123233995736766e-17; const int q = ((int)kq) & 3;
            const double y2 = yv * yv;
            const double sn = yv * (1.0 - y2 / 6.0 * (1.0 - y2 / 20.0 * (1.0 - y2 / 42.0 * (1.0 - y2 / 72.0 * (1.0 - y2 / 110.0 * (1.0 - y2 / 156.0))))));
            const double cs = 1.0 - y2 / 2.0 * (1.0 - y2 / 12.0 * (1.0 - y2 / 30.0 * (1.0 - y2 / 56.0 * (1.0 - y2 / 90.0 * (1.0 - y2 / 132.0)))));
            double so, co; if (q == 0) { so = sn; co = cs; } else if (q == 1) { so = cs; co = -sn; } else if (q == 2) { so = -sn; co = -cs; } else { so = -cs; co = sn; }
            ROPE[idx] = make_float2((float)co, (float)so); }
        for (int m = gw; m < MTOK; m += NGW) row_update(x_in + (size_t)m * DM, nullptr, nullptr, xres + (size_t)m * DM, XB + (size_t)m * DM, INVA + m, lane);
        SEAM(0);
    }

    for (int l = 0; l < DEPTH; ++l) {
        const int pb = 1 + NPH_LAYER * l;
        if (PH_EN(0) && IN(pb + 0)) {
            pg8::Gemm g{XB, (const bf16*)(ws + WS_WIN + l * WIN_BYTES), MTOK, NPROJ, DM}; pg8::StaticOrder S; S.init(MTOK, NPROJ, G, bx);
            pg8::EpiRowScaleBf16<0> E{PROJ, NPROJ, INVA};
            pg8::gemm_phase<pg8::EpiRowScaleBf16<0>, pg8::StaticOrder, true, true>(lds, g, S, E);
            SEAM(pb + 0);
        }
        if (PH_EN(1) && IN(pb + 1)) {
            PHASE_LOCALS
            LAS float* part = (LAS float*)lds;
            for (int u = bx; u < BATCH * NH * NBLK; u += G) {
                const int b = u / (NH * NBLK), h = (u / NBLK) % NH, n = u % NBLK;
                const int d = tid & 127, rq = tid >> 7, i16 = d & 15;
                float sum = 0.f;
                for (int i = 0; i < 64; ++i) { const int t = b * SEQ + n * MOBA_BLK + rq * 64 + i;
                    bf16* p = PROJ + (size_t)t * NPROJ + CK + h * HD + d; float v = bf2f(*p);
                    const float o = __shfl_xor(v, 16);
                    if (d < 32) { const float2 cs = ROPE[t * 16 + i16]; const float r = (d < 16) ? (v * cs.x - o * cs.y) : (v * cs.x + o * cs.y); const bf16 rb = (bf16)f2bf(r); *p = rb; v = bf2f(rb); }
                    sum += v; }
                part[rq * 128 + d] = sum;
                __syncthreads();
                if (tid < 128) KMEAN[(size_t)u * 128 + tid] = ((part[tid] + part[128 + tid]) + (part[256 + tid] + part[384 + tid])) * (1.f / 256.f);
                __syncthreads();
            }
            for (int idx = gt; idx < MTOK * NH * 16; idx += NGT) { const int t = idx >> 7, h = (idx >> 4) & 7, i = idx & 15;
                bf16* p = PROJ + (size_t)t * NPROJ + CQ + h * HD + i; const float x1 = bf2f(p[0]), x2 = bf2f(p[16]); const float2 cs = ROPE[t * 16 + i];
                p[0] = (bf16)f2bf(x1 * cs.x - x2 * cs.y); p[16] = (bf16)f2bf(x2 * cs.x + x1 * cs.y); }
            const float* cw = conv_w + (size_t)l * 4 * CONVD; const float* cb = conv_b + (size_t)l * CONVD;
            for (int idx = gt; idx < MTOK * CONVD; idx += NGT) { const int t = idx / CONVD, j = idx % CONVD, s = t % SEQ;
                float a = cb[j];
#pragma unroll
                for (int k = 0; k < 4; ++k) { const int ss = s - 3 + k; if (ss >= 0) a += cw[k * CONVD + j] * bf2f(PROJ[(size_t)(t - 3 + k) * NPROJ + CX + j]); }
                XBC[idx] = silu_f(a); }
            for (int idx = gt; idx < MTOK * SH; idx += NGT) { const int t = idx >> 4, h = idx & 15;
                DTB[idx] = softplus_f(bf2f(PROJ[(size_t)t * NPROJ + CDT + h]) + dt_bias[l * SH + h]); }
            SEAM(pb + 1);
        }
        if (PH_EN(2) && IN(pb + 2)) {
            PHASE_LOCALS
            for (int u = bx; u < BATCH * SH; u += G) {
                const int b = u / SH, h = u % SH, g = h >> 3, p = tid >> 3, nq = tid & 7;
                const float A = -__expf(a_log[l * SH + h]), Dh = d_skip[l * SH + h];
                float st[16];
#pragma unroll
                for (int j = 0; j < 16; ++j) st[j] = 0.f;
                for (int s = 0; s < SEQ; ++s) { const size_t t = (size_t)b * SEQ + s;
                    const float dt = DTB[t * SH + h], xv = XBC[t * CONVD + h * SP + p], dA = __expf(dt * A), dx = dt * xv;
                    const GAS f32x4* Bp = (const GAS f32x4*)(XBC + t * CONVD + 1024 + g * SN + nq * 16); const GAS f32x4* Cp = (const GAS f32x4*)(XBC + t * CONVD + 1280 + g * SN + nq * 16);
                    float yv = 0.f;
#pragma unroll
                    for (int j4 = 0; j4 < 4; ++j4) { const f32x4 bv = Bp[j4], cv = Cp[j4];
#pragma unroll
                        for (int j = 0; j < 4; ++j) { float& sj = st[j4 * 4 + j]; sj = sj * dA + dx * bv[j]; yv += sj * cv[j]; } }
                    yv += __shfl_xor(yv, 1); yv += __shfl_xor(yv, 2); yv += __shfl_xor(yv, 4);
                    if (nq == 0) YS[t * SW + h * SP + p] = yv + Dh * xv; }
            }
            static_assert(att::KVP == NPROJ && att::OP == DM && att::ATT_LDS_BYTES <= RING_BYTES, "attention body geometry");
            for (int u = bx; u < BATCH * NH * NBLK; u += G) {
                const int xcd = u & 7, k = u >> 3, pair = xcd * 4 + (k >> 3), qb = 7 - (k & 7), b = pair >> 3, h = pair & 7;
                att::BlockRef cur;
                cur.Q = PROJ + (size_t)(b * SEQ + qb * MOBA_BLK) * NPROJ + CQ + h * HD; cur.K = PROJ + (size_t)(b * SEQ) * NPROJ + CK + h * HD; cur.V = PROJ + (size_t)(b * SEQ) * NPROJ + CV + h * HD;
                cur.O = MIX + (size_t)(b * SEQ + qb * MOBA_BLK) * DM + h * HD; cur.kmean = KMEAN + (size_t)((b * NH + h) * NBLK) * 128; cur.P0 = qb * MOBA_BLK;
                att::Seam S;
                att::moba_prime(cur, (char*)lds_raw, S, tid);
                att::moba_block(cur, cur, (char*)lds_raw, S, tid);
            }
            SEAM(pb + 2);
        }
        if (PH_EN(3) && IN(pb + 3)) {
            PHASE_LOCALS
            for (int t = gw; t < MTOK; t += NGW) {
                { bf16* ar = MIX + (size_t)t * DM; float v[16]; float ss = 0.f;
#pragma unroll
                  for (int hlf = 0; hlf < 2; ++hlf) { const v4u w = *(const GAS v4u*)(ar + hlf * 512 + lane * 8); const unsigned w4[4] = {w.x, w.y, w.z, w.w};
#pragma unroll
                      for (int e = 0; e < 4; ++e) { v[hlf * 8 + 2 * e] = __uint_as_float(w4[e] << 16); v[hlf * 8 + 2 * e + 1] = __uint_as_float(w4[e] & 0xffff0000u); } }
#pragma unroll
                  for (int e = 0; e < 16; ++e) ss += v[e] * v[e];
                  const float inv = 1.0f / sqrtf(wave_sum(ss) * (1.f / AW) + NORM_EPS);
#pragma unroll
                  for (int hlf = 0; hlf < 2; ++hlf) { const float* gp = attn_norm + l * AW + hlf * 512 + lane * 8; v4u o;
                      o.x = pk2(v[hlf * 8 + 0] * inv * gp[0], v[hlf * 8 + 1] * inv * gp[1]); o.y = pk2(v[hlf * 8 + 2] * inv * gp[2], v[hlf * 8 + 3] * inv * gp[3]);
                      o.z = pk2(v[hlf * 8 + 4] * inv * gp[4], v[hlf * 8 + 5] * inv * gp[5]); o.w = pk2(v[hlf * 8 + 6] * inv * gp[6], v[hlf * 8 + 7] * inv * gp[7]);
                      *(GAS v4u*)(ar + hlf * 512 + lane * 8) = o; } }
#pragma unroll
                for (int g = 0; g < 2; ++g) { const int c0 = g * 512 + lane * 8; float v[8]; float ss = 0.f;
                    const v4u zw = *(const GAS v4u*)(PROJ + (size_t)t * NPROJ + CZ + c0); const unsigned z4[4] = {zw.x, zw.y, zw.z, zw.w};
#pragma unroll
                    for (int e = 0; e < 8; ++e) { const float z = (e & 1) ? __uint_as_float(z4[e >> 1] & 0xffff0000u) : __uint_as_float(z4[e >> 1] << 16); v[e] = YS[(size_t)t * SW + c0 + e] * silu_f(z); ss += v[e] * v[e]; }
                    const float inv = 1.0f / sqrtf(wave_sum(ss) * (1.f / 512.f) + NORM_EPS); const float* gp = ssd_norm + l * SW + c0; v4u o;
                    o.x = pk2(v[0] * inv * gp[0], v[1] * inv * gp[1]); o.y = pk2(v[2] * inv * gp[2], v[3] * inv * gp[3]); o.z = pk2(v[4] * inv * gp[4], v[5] * inv * gp[5]); o.w = pk2(v[6] * inv * gp[6], v[7] * inv * gp[7]);
                    *(GAS v4u*)(MIX + (size_t)t * DM + AW + c0) = o; }
            }
            SEAM(pb + 3);
        }
        if (PH_EN(4) && IN(pb + 4)) {
            pg8::Gemm g{MIX, (const bf16*)(ws + WS_WOUT + l * WOUT_BYTES), MTOK, DM, DM}; pg8::StaticOrder S; S.init(MTOK, DM, G, bx);
            pg8::EpiF32 E{Y, DM};
            pg8::gemm_phase<pg8::EpiF32, pg8::StaticOrder, false, true>(lds, g, S, E);
            SEAM(pb + 4);
        }
        if (PH_EN(5) && IN(pb + 5)) {
            PHASE_LOCALS
            for (int m = gw; m < MTOK; m += NGW) row_update(xres + (size_t)m * DM, Y + (size_t)m * DM, post_mix + l * DM, xres + (size_t)m * DM, XB + (size_t)m * DM, INVB + m, lane);
            SEAM(pb + 5);
        }
        if (PH_EN(6) && IN(pb + 6)) {
            pg8::Gemm g{XB, (const bf16*)(ws + WS_WUP + l * WUP_BYTES), MTOK, DFF, DM}; pg8::StaticOrder S; S.init(MTOK, DFF, G, bx);
            pg8::EpiRowScaleBf16<1> E{HID, DFF, INVB};
            pg8::gemm_phase<pg8::EpiRowScaleBf16<1>, pg8::StaticOrder, true, true>(lds, g, S, E);
            SEAM(pb + 6);
        }
        if (PH_EN(7) && IN(pb + 7)) {
            pg8::Gemm g{HID, (const bf16*)(ws + WS_WDN + l * WDN_BYTES), MTOK, DM, DFF}; pg8::StaticOrder S; S.init(MTOK, DM, G, bx);
            pg8::EpiF32 E{Y, DM};
            pg8::gemm_phase<pg8::EpiF32, pg8::StaticOrder, false, true>(lds, g, S, E);
            SEAM(pb + 7);
        }
        if (PH_EN(8) && IN(pb + 8)) {
            PHASE_LOCALS
            for (int m = gw; m < MTOK; m += NGW) row_update(xres + (size_t)m * DM, Y + (size_t)m * DM, post_mlp + l * DM, xres + (size_t)m * DM, XB + (size_t)m * DM, INVA + m, lane);
            SEAM(pb + 8);
        }
    }
#undef IN
#undef BOTH
#undef SEAM
}

#ifndef N_LAUNCH_MODE
#define N_LAUNCH_MODE 0
#endif
extern "C" void kernel_launch(void* const* d_in, const int* in_sizes, int n_in, void* d_out, int out_size, void* d_ws, size_t ws_size, hipStream_t stream) {
    static int grid = 0;
    if (grid == 0) {
        if (n_in != 17 || out_size != MTOK * DM || ws_size < WS_END) { fprintf(stderr, "kernel_launch: unexpected shapes (n_in %d out %d ws %zu)\n", n_in, out_size, ws_size); grid = -1; return; }
        int dev = 0, cus = 0;
        if (hipGetDevice(&dev) != hipSuccess || hipDeviceGetAttribute(&cus, hipDeviceAttributeMultiprocessorCount, dev) != hipSuccess) { grid = -1; return; }
        if (hipFuncSetAttribute((const void*)fwd_kernel, hipFuncAttributeMaxDynamicSharedMemorySize, LDS_BYTES) != hipSuccess) { fprintf(stderr, "kernel_launch: hipFuncSetAttribute failed\n"); grid = -1; return; }
        (void)hipGetLastError();
        grid = cus;
    }
    if (grid < 0) return;
    (void)hipMemsetAsync((char*)d_ws + WS_CTL, 0, CTL_ZERO_BYTES, stream);
    Args a{};
    for (int i = 0; i < 17; ++i) a.in[i] = d_in[i];
    a.out = (float*)d_out; a.ws = (unsigned char*)d_ws;
#if N_LAUNCH_MODE == 1
    a.ph_lo = 0; a.ph_hi = NPHASES;
    hipLaunchKernelGGL(fwd_kernel, dim3(grid), dim3(NWAVES * 64), LDS_BYTES, stream, a);
#else
    for (int p = 0; p < NPHASES; ++p) { a.ph_lo = p; a.ph_hi = p + 1; hipLaunchKernelGGL(fwd_kernel, dim3(grid), dim3(NWAVES * 64), LDS_BYTES, stream, a); }
#endif
}
```

```cpp
#include <hip/hip_runtime.h>
#include <cstdio>
#include <cstdint>
#include <cmath>
#define N_LAUNCH_MODE 1
namespace pg8 {
#define PG8_LAS __attribute__((address_space(3)))
typedef unsigned short bf16_t;
typedef short bf16x8 __attribute__((ext_vector_type(8)));
typedef float f32x4 __attribute__((ext_vector_type(4)));
typedef unsigned u32x4 __attribute__((ext_vector_type(4)));
constexpr int BM = 256, BK = 64, HALF = 128, HTB = HALF * BK * 2  , STAGE_BYTES = 8 * HTB, NXCD = 8, WGM = 8;

__host__ __device__ __forceinline__ int lds_byte(int r, int c) { const int st = (r >> 4) * 2 + (c >> 5), rr = r & 15, cc = c & 31, ob = rr * 64 + cc * 2; return st * 1024 + (ob ^ (((ob >> 9) & 1) << 5)); }
__host__ __device__ __forceinline__ void stage_rc(int b, int& R, int& C) { const int st = b / 1024, sb = b % 1024, swz = sb ^ (((sb >> 9) & 1) << 5); R = (st >> 1) * 16 + swz / 64; C = (st & 1) * 32 + (swz % 64) / 2; }
__host__ __device__ __forceinline__ int perm32(int rho) { const int n = rho >> 4, i = rho & 15; return 8 * (i >> 2) + 4 * n + (i & 3); }

struct Unit { int pm, pn; };
struct Gemm { const bf16_t* A; const bf16_t* Bt; int M, N, K; };

struct StaticOrder {
    int nM, nN, nwg, G, c;
    __host__ __device__ void init(int M, int N, int G_, int c_) { nM = M / BM; nN = N / BM; nwg = nM * nN; G = G_; c = c_; }
    __host__ __device__ bool next(int i, Unit& u) const {
        const long L = (long)i * G + c; if (L >= nwg) return false;
        int wgid = (int)L; { const int q = nwg / NXCD, r = nwg % NXCD, xcd = wgid % NXCD, off = wgid / NXCD; wgid = (xcd < r ? xcd * (q + 1) : r * (q + 1) + (xcd - r) * q) + off; }
        const int nig = WGM * nN, gid = wgid / nig, fm = gid * WGM, gsz = (nM - fm) < WGM ? (nM - fm) : WGM;
        u.pm = fm + ((wgid % nig) % gsz); u.pn = (wgid % nig) / gsz; return true;
    }
    __device__ __forceinline__ void a_ready(const Unit&) const {}
    __device__ __forceinline__ void done(const Unit&) const {}
};

__device__ __forceinline__ unsigned cvt_pk_bf16(float lo, float hi) { unsigned r; asm volatile("v_cvt_pk_bf16_f32 %0, %1, %2" : "=v"(r) : "v"(lo), "v"(hi)); return r; }

struct EpiF32 {
    static constexpr bool PERM = false, AFTER_DRAIN = false;
    float* C; int ldc;
    __device__ __forceinline__ void operator()(const f32x4 (&acc)[2][2][4][2], const Unit& u, int wr, int wc, int fr, int fq) const {
        const int row0 = u.pm * BM + wr * 64 + fr, col0 = u.pn * BM + wc * 32 + 4 * fq;
#pragma unroll
        for (int ai = 0; ai < 2; ++ai)
#pragma unroll
            for (int m = 0; m < 4; ++m) { float* rowp = C + (size_t)(row0 + ai * HALF + m * 16) * ldc + col0;
#pragma unroll
                for (int bj = 0; bj < 2; ++bj)
#pragma unroll
                    for (int n = 0; n < 2; ++n) *(f32x4*)(rowp + bj * HALF + n * 16) = acc[ai][bj][m][n]; }
    }
};
template <int ACT> struct EpiRowScaleBf16 {
    static constexpr bool PERM = true, AFTER_DRAIN = false;
    bf16_t* O; int ldc; const float* rs;
    __device__ __forceinline__ void operator()(const f32x4 (&acc)[2][2][4][2], const Unit& u, int wr, int wc, int fr, int fq) const {
        const int row0 = u.pm * BM + wr * 64 + fr, col0 = u.pn * BM + wc * 32 + 8 * fq;
#pragma unroll
        for (int ai = 0; ai < 2; ++ai)
#pragma unroll
            for (int m = 0; m < 4; ++m) { const int r = row0 + ai * HALF + m * 16; const float s = rs[r]; bf16_t* rowp = O + (size_t)r * ldc + col0;
#pragma unroll
                for (int bj = 0; bj < 2; ++bj) { f32x4 v0 = acc[ai][bj][m][0] * s, v1 = acc[ai][bj][m][1] * s;
                    if (ACT == 1) {
#pragma unroll
                        for (int j = 0; j < 4; ++j) { const float a = fmaxf(v0[j], 0.f), b = fmaxf(v1[j], 0.f); v0[j] = a * a; v1[j] = b * b; } }
                    u32x4 w; w.x = cvt_pk_bf16(v0[0], v0[1]); w.y = cvt_pk_bf16(v0[2], v0[3]); w.z = cvt_pk_bf16(v1[0], v1[1]); w.w = cvt_pk_bf16(v1[2], v1[3]);
                    *(u32x4*)(rowp + bj * HALF) = w; } }
    }
};

template <class Epi, class Sched, bool ALIGN_EPI = false, bool SP2 = false>
__device__ __forceinline__ void gemm_phase(PG8_LAS unsigned char* lds, const Gemm g, const Sched& S, const Epi& E, int tid_l  ) {
    asm volatile("" : "+v"(tid_l));
    const int tid = tid_l, wid = __builtin_amdgcn_readfirstlane(tid >> 6), lane = tid & 63, wr = wid >> 2, wc = wid & 3, fr = lane & 15, fq = lane >> 4;
    const int K = g.K, nt = K / BK;
    unsigned voffA[2], voffB[2];
#pragma unroll
    for (int i = 0; i < 2; ++i) { int R, C; stage_rc(tid * 16 + i * 8192, R, C); const int Rb = Epi::PERM ? ((R & ~31) + perm32(R & 31)) : R;
        voffA[i] = (unsigned)(R * K + C) * 2u; voffB[i] = (unsigned)(Rb * K + C) * 2u; }
    const size_t kstep = (size_t)(BK * 2);
    const size_t hstep = (size_t)HALF * K * 2;
    const size_t tstep = 2 * hstep;
    const unsigned ldsw = (unsigned)wid * 1024u;
    const int aoff = lds_byte(wr * 64 + fr, fq * 8), boff = lds_byte(wc * 32 + fr, fq * 8);
#define PG8_SA(b, h) (((b) * 2 + (h)) * HTB)
#define PG8_SB(b, h) ((4 + (b) * 2 + (h)) * HTB)
#define PG8_STAGE(bufoff, gbase, voff) do { _Pragma("unroll") for (int _i = 0; _i < 2; ++_i) \
        __builtin_amdgcn_global_load_lds((const unsigned*)((const char*)(gbase) + (voff)[_i]), (PG8_LAS unsigned*)(lds + (bufoff) + ldsw + _i * 8192), 16, 0, 0); } while (0)
#define PG8_LDA(dst, b, h) do { _Pragma("unroll") for (int m = 0; m < 4; ++m) _Pragma("unroll") for (int k = 0; k < 2; ++k) dst[m][k] = *(const PG8_LAS bf16x8*)(lds + PG8_SA(b, h) + aoff + m * 2048 + k * 1024); } while (0)
#define PG8_LDB(dst, b, h) do { _Pragma("unroll") for (int n = 0; n < 2; ++n) _Pragma("unroll") for (int k = 0; k < 2; ++k) dst[n][k] = *(const PG8_LAS bf16x8*)(lds + PG8_SB(b, h) + boff + n * 2048 + k * 1024); } while (0)
#define PG8_MMA(ai, bj, At, Bt) do { __builtin_amdgcn_s_setprio(1); _Pragma("unroll") for (int m = 0; m < 4; ++m) _Pragma("unroll") for (int n = 0; n < 2; ++n) _Pragma("unroll") for (int k = 0; k < 2; ++k) \
        acc[ai][bj][m][n] = __builtin_amdgcn_mfma_f32_16x16x32_bf16(Bt[n][k], At[m][k], acc[ai][bj][m][n], 0, 0, 0); __builtin_amdgcn_s_setprio(0); } while (0)
#define PG8_WAIT_V(n) asm volatile("s_waitcnt vmcnt(" #n ")" ::: "memory")
#define PG8_WAIT_L(n) asm volatile("s_waitcnt lgkmcnt(" #n ")" ::: "memory")
#define PG8_BAR __builtin_amdgcn_s_barrier()
#define PG8_SCHED __builtin_amdgcn_sched_barrier(0)
    Unit cur, nxt; int ui = 0;
    if (!S.next(0, cur)) return;
    f32x4 acc[2][2][4][2];
#pragma unroll
    for (int a = 0; a < 2; ++a)
#pragma unroll
        for (int b = 0; b < 2; ++b)
#pragma unroll
            for (int m = 0; m < 4; ++m)
#pragma unroll
                for (int n = 0; n < 2; ++n) acc[a][b][m][n] = (f32x4){0.f, 0.f, 0.f, 0.f};
    bf16x8 At[4][2], B0[2][2], B1[2][2];
    const char* cA = (const char*)g.A + (size_t)cur.pm * tstep; const char* cB = (const char*)g.Bt + (size_t)cur.pn * tstep;
    S.a_ready(cur);
    if constexpr (SP2) {
        PG8_STAGE(PG8_SB(0, 0), cB, voffB); PG8_STAGE(PG8_SB(0, 1), cB + hstep, voffB); PG8_STAGE(PG8_SA(0, 0), cA, voffA); PG8_STAGE(PG8_SA(0, 1), cA + hstep, voffA);
        if (wr == 1) PG8_BAR;
        PG8_WAIT_V(2); PG8_BAR;
        PG8_STAGE(PG8_SB(1, 0), cB + kstep, voffB); PG8_STAGE(PG8_SA(1, 0), cA + kstep, voffA); PG8_STAGE(PG8_SB(1, 1), cB + hstep + kstep, voffB);
        PG8_WAIT_V(6); PG8_BAR;
    } else {
        PG8_STAGE(PG8_SB(0, 0), cB, voffB); PG8_STAGE(PG8_SA(0, 0), cA, voffA); PG8_STAGE(PG8_SB(0, 1), cB + hstep, voffB); PG8_STAGE(PG8_SA(0, 1), cA + hstep, voffA);
        if (wr == 1) PG8_BAR;
        PG8_WAIT_V(4); PG8_BAR;
        PG8_STAGE(PG8_SB(1, 0), cB + kstep, voffB); PG8_STAGE(PG8_SA(1, 0), cA + kstep, voffA); PG8_STAGE(PG8_SB(1, 1), cB + hstep + kstep, voffB);
        PG8_WAIT_V(6); PG8_BAR;
    }
    for (;;) {
        const bool has_next = S.next(ui + 1, nxt);
        const char* nA = has_next ? (const char*)g.A + (size_t)nxt.pm * tstep : cA; const char* nB = has_next ? (const char*)g.Bt + (size_t)nxt.pn * tstep : cB;
        for (int t = 0; t < nt; t += 2) {
            const bool last = (t == nt - 2);
            const char* a1 = cA + (size_t)(t + 1) * kstep;
            const char* a2 = last ? nA : cA + (size_t)(t + 2) * kstep; const char* b2 = last ? nB : cB + (size_t)(t + 2) * kstep;
            const char* a3 = a2 + kstep; const char* b3 = b2 + kstep;
            if (last && has_next) S.a_ready(nxt);
            if constexpr (SP2) {
            PG8_LDB(B0, 0, 0); PG8_LDB(B1, 0, 1); PG8_SCHED; PG8_LDA(At, 0, 0); PG8_STAGE(PG8_SA(1, 1), a1 + hstep, voffA);
            PG8_WAIT_V(8); PG8_WAIT_L(0); PG8_BAR; PG8_MMA(0, 0, At, B0); PG8_MMA(0, 1, At, B1); PG8_BAR; PG8_SCHED;
            PG8_LDA(At, 0, 1); PG8_STAGE(PG8_SB(0, 0), b2, voffB); PG8_STAGE(PG8_SB(0, 1), b2 + hstep, voffB); PG8_STAGE(PG8_SA(0, 0), a2, voffA);
            PG8_WAIT_V(8); PG8_WAIT_L(0); PG8_BAR; PG8_MMA(1, 0, At, B0); PG8_MMA(1, 1, At, B1); PG8_BAR; PG8_SCHED;
            PG8_LDB(B0, 1, 0); PG8_LDB(B1, 1, 1); PG8_SCHED; PG8_LDA(At, 1, 0); PG8_STAGE(PG8_SA(0, 1), a2 + hstep, voffA);
            PG8_WAIT_V(8); PG8_WAIT_L(0); PG8_BAR; PG8_MMA(0, 0, At, B0); PG8_MMA(0, 1, At, B1); PG8_BAR; PG8_SCHED;
            PG8_LDA(At, 1, 1); PG8_STAGE(PG8_SB(1, 0), b3, voffB); PG8_STAGE(PG8_SB(1, 1), b3 + hstep, voffB); PG8_STAGE(PG8_SA(1, 0), a3, voffA);
            PG8_WAIT_V(8); PG8_WAIT_L(0); PG8_BAR; PG8_MMA(1, 0, At, B0); PG8_MMA(1, 1, At, B1); PG8_BAR; PG8_SCHED;
            } else {
            PG8_LDB(B0, 0, 0); PG8_SCHED; PG8_LDA(At, 0, 0); PG8_STAGE(PG8_SA(1, 1), a1 + hstep, voffA);
            PG8_WAIT_L(8); PG8_BAR; PG8_WAIT_L(0); PG8_MMA(0, 0, At, B0); PG8_BAR; PG8_SCHED;
            PG8_LDB(B1, 0, 1); PG8_STAGE(PG8_SB(0, 0), b2, voffB);
            PG8_BAR; PG8_WAIT_L(0); PG8_MMA(0, 1, At, B1); PG8_BAR;
            PG8_LDA(At, 0, 1); PG8_STAGE(PG8_SA(0, 0), a2, voffA);
            PG8_BAR; PG8_WAIT_L(0); PG8_MMA(1, 0, At, B0); PG8_BAR; PG8_SCHED;
            PG8_STAGE(PG8_SB(0, 1), b2 + hstep, voffB);
            PG8_WAIT_V(6); PG8_BAR; PG8_MMA(1, 1, At, B1); PG8_BAR;
            PG8_LDB(B0, 1, 0); PG8_SCHED; PG8_LDA(At, 1, 0); PG8_STAGE(PG8_SA(0, 1), a2 + hstep, voffA);
            PG8_WAIT_L(8); PG8_BAR; PG8_WAIT_L(0); PG8_MMA(0, 0, At, B0); PG8_BAR; PG8_SCHED;
            PG8_LDB(B1, 1, 1); PG8_STAGE(PG8_SB(1, 0), b3, voffB);
            PG8_BAR; PG8_WAIT_L(0); PG8_MMA(0, 1, At, B1); PG8_BAR;
            PG8_LDA(At, 1, 1); PG8_STAGE(PG8_SA(1, 0), a3, voffA);
            PG8_BAR; PG8_WAIT_L(0); PG8_MMA(1, 0, At, B0); PG8_BAR; PG8_SCHED;
            PG8_STAGE(PG8_SB(1, 1), b3 + hstep, voffB);
            PG8_WAIT_V(6); PG8_BAR; PG8_MMA(1, 1, At, B1); PG8_BAR;
            }
        }
        if constexpr (ALIGN_EPI) { if (wr == 0) PG8_BAR; }
        if constexpr (!Epi::AFTER_DRAIN) { E(acc, cur, wr, wc, fr, fq); S.done(cur); }
        if (!has_next) break;
#pragma unroll
        for (int a = 0; a < 2; ++a)
#pragma unroll
            for (int b = 0; b < 2; ++b)
#pragma unroll
                for (int m = 0; m < 4; ++m)
#pragma unroll
                    for (int n = 0; n < 2; ++n) acc[a][b][m][n] = (f32x4){0.f, 0.f, 0.f, 0.f};
        cur = nxt; cA = nA; cB = nB; ++ui;
        if constexpr (ALIGN_EPI) { if (wr == 1) PG8_BAR; }
    }
    PG8_WAIT_V(0);
    if constexpr (!ALIGN_EPI) { if (wr == 0) PG8_BAR; }
    PG8_BAR;
    if constexpr (Epi::AFTER_DRAIN) { E.fused(acc, cur, wr, wc, fr, fq, lds, wid, lane); S.done(cur); }
#undef PG8_SA
#undef PG8_SB
#undef PG8_STAGE
#undef PG8_LDA
#undef PG8_LDB
#undef PG8_MMA
#undef PG8_WAIT_V
#undef PG8_WAIT_L
#undef PG8_BAR
#undef PG8_SCHED
}
}
#define GAS __attribute__((address_space(1)))
#define LAS __attribute__((address_space(3)))
typedef unsigned short bf16;
typedef unsigned v4u __attribute__((ext_vector_type(4)));
typedef float f32x4 __attribute__((ext_vector_type(4)));
typedef short bf16x8 __attribute__((ext_vector_type(8)));
typedef GAS unsigned gu32;
typedef GAS unsigned long long gu64;
#define RLX_AGENT __ATOMIC_RELAXED, __HIP_MEMORY_SCOPE_AGENT
#define LDS_WAIT() asm volatile("s_waitcnt lgkmcnt(0)" ::: "memory")
#define VM_WAIT() asm volatile("s_waitcnt vmcnt(0)" ::: "memory")
__device__ __forceinline__ unsigned long long rt() { return __builtin_amdgcn_s_memrealtime(); }
__device__ __forceinline__ unsigned f2bf(float f) { unsigned u = __builtin_bit_cast(unsigned, f); return (u + 0x7fffu + ((u >> 16) & 1u)) >> 16; }
__device__ __forceinline__ unsigned pk2(float lo, float hi) { return f2bf(lo) | (f2bf(hi) << 16); }

#define XB_TMO      128
#define XB_XCNT(j)  (256  + 64 * (j))
#define XB_XSUB(j)  (1280 + 64 * (j))
#define XB_XGEN(j)  (2304 + 64 * (j))
#define XB_TOP      3328
#define XB_TOPGEN   3392
#define XCD_BAR_WORDS 3456
#define XB_SPIN_CAP (1u << 22)

__device__ __forceinline__ unsigned xb_ld(unsigned* p)              { return __hip_atomic_load(p, __ATOMIC_RELAXED, __HIP_MEMORY_SCOPE_AGENT); }
__device__ __forceinline__ unsigned xb_add(unsigned* p, unsigned v) { return __hip_atomic_fetch_add(p, v, __ATOMIC_RELAXED, __HIP_MEMORY_SCOPE_AGENT); }
__device__ __forceinline__ unsigned xb_xcc_id() { return (unsigned)__builtin_amdgcn_s_getreg((3 << 11) | 20) & 0xFu; }
#define XB_SPIN(cond, bar) do { unsigned _sp = 0; while (cond) { __builtin_amdgcn_s_sleep(1); \
    if ((++_sp & 255u) == 0u) { if (xb_ld(&(bar)[XB_TMO])) break; if (_sp > XB_SPIN_CAP) { atomicAdd(&(bar)[XB_TMO], 1u); break; } } } } while (0)

struct XcdBarrier {
    unsigned* bar; unsigned x;
    volatile LAS unsigned* st;
};

__device__ __forceinline__ XcdBarrier xcd_barrier_post(unsigned* bar, volatile LAS unsigned* st) {
    XcdBarrier b; b.bar = bar; b.x = xb_xcc_id(); b.st = st;
    if (threadIdx.x == 0) (void)xb_add(&bar[XB_XCNT(b.x)], 1u);
    return b;
}
__device__ __forceinline__ void xcd_barrier_complete(unsigned* bar, unsigned x, unsigned& nloc, unsigned& nx) {
    const unsigned G = gridDim.x * gridDim.y * gridDim.z;
    unsigned sum, cnt, mine, sp = 0u;
    for (;;) {
        sum = 0u; cnt = 0u; mine = 0u;
#pragma unroll
        for (unsigned j = 0; j < 16; ++j) { const unsigned c = xb_ld(&bar[XB_XCNT(j)]); sum += c; cnt += (c > 0u) ? 1u : 0u; mine = (j == x) ? c : mine; }
        if (sum == G) break;
        __builtin_amdgcn_s_sleep(1);
        if ((++sp & 255u) == 0u) { if (xb_ld(&bar[XB_TMO])) break; if (sp > XB_SPIN_CAP) { atomicAdd(&bar[XB_TMO], 1u); break; } }
    }
    nloc = mine > 0u ? mine : 1u; nx = cnt > 0u ? cnt : 1u;
}

__device__ __forceinline__ void xcd_barrier(const XcdBarrier& b) {
    asm volatile("s_waitcnt vmcnt(0)" ::: "memory");
    __syncthreads();
    if (threadIdx.x == 0) {
        unsigned* bar = b.bar;
        __builtin_amdgcn_s_waitcnt(0);
        unsigned nloc = b.st[0], nx = b.st[1];
        if (nloc == 0u) { xcd_barrier_complete(bar, b.x, nloc, nx); b.st[0] = nloc; b.st[1] = nx; }
        const unsigned old = xb_add(&bar[XB_XSUB(b.x)], 1u);
        const unsigned gen = old / nloc;
        if (old + 1u == (gen + 1u) * nloc) {
            __builtin_amdgcn_fence(__ATOMIC_RELEASE, "agent");
            asm volatile("s_waitcnt vmcnt(0)" ::: "memory");
            const unsigned og = xb_add(&bar[XB_TOP], 1u);
            const unsigned tg = og / nx;
            if (og + 1u == (tg + 1u) * nx) xb_add(&bar[XB_TOPGEN], 1u);
            else XB_SPIN(xb_ld(&bar[XB_TOPGEN]) == tg, bar);
            __builtin_amdgcn_fence(__ATOMIC_ACQUIRE, "agent");
            xb_add(&bar[XB_XGEN(b.x)], 1u);
            asm volatile("s_waitcnt vmcnt(0)" ::: "memory");
        } else {
            XB_SPIN(xb_ld(&bar[XB_XGEN(b.x)]) == gen, bar);
            __builtin_amdgcn_fence(__ATOMIC_ACQUIRE, "agent");
            asm volatile("s_waitcnt vmcnt(0)" ::: "memory");
        }
    }
    __syncthreads();
}
namespace att {
typedef unsigned short abf;
typedef short bf16x8 __attribute__((ext_vector_type(8)));
typedef short s16x4 __attribute__((ext_vector_type(4)));
typedef float f32x16 __attribute__((ext_vector_type(16)));
typedef float f32x4 __attribute__((ext_vector_type(4)));
typedef unsigned u32x4 __attribute__((ext_vector_type(4)));
constexpr float SCALE = 0.08838834764831845f;
constexpr float THR = 8.f;
constexpr int D = 128, NW = 8, QBLK = 32, KVBLK = 64, QB = NW * QBLK;
constexpr int KVP = 5888, OP = 2048;
constexpr int SHM_V = KVBLK * D * 2, SHM_K = KVBLK * D * 2;
constexpr int ATT_LDS_BYTES = 2 * SHM_V + 2 * SHM_K + NW * 64 * 4;

#define KSWZ(row, colB) ((row) * 256 + ((colB) ^ (((row) & 7) << 4)))
#define SBAR() __builtin_amdgcn_sched_barrier(0)
__device__ __forceinline__ int v_st(int k, int c) { const int kk = (k & ~0xC) | ((k & 4) << 1) | ((k & 8) >> 1); return ((kk >> 3) * 4 + (c >> 5)) * 512 + ((kk & 7) * 32 + (c & 31)) * 2; }
__device__ __forceinline__ int v_rd_base(int lane) { return ((lane & 3) << 3) | (((lane >> 2) & 3) << 6) | (((lane >> 4) & 1) << 5) | (((lane >> 5) & 1) << 8); }
constexpr int v_rd_off(int d0, int ks, int half) { return d0 * 512 + ks * 4096 + half * 2048; }
__device__ __forceinline__ int crow(int r, int hi) { return (r & 3) + 8 * (r >> 2) + 4 * hi; }
__device__ __forceinline__ unsigned cvtpk(float lo, float hi) { unsigned r; asm volatile("v_cvt_pk_bf16_f32 %0, %1, %2" : "=v"(r) : "v"(lo), "v"(hi)); return r; }
__device__ __forceinline__ bf16x8 load8(const abf* p) { return *reinterpret_cast<const bf16x8*>(p); }
__device__ __forceinline__ void mask_tile(f32x16& p0, f32x16& p1, int dq) {
    const float NEG = -__builtin_inff();
#pragma unroll
    for (int r = 0; r < 16; ++r) {
        const int c = (r & 3) + 8 * (r >> 2);
        if (dq - c < 0) p0[r] = NEG;
        if (dq - c - 32 < 0) p1[r] = NEG;
    }
}
__device__ __forceinline__ void kill_tile(f32x16& p0, f32x16& p1, bool keep) {
    const float NEG = -__builtin_inff();
#pragma unroll
    for (int r = 0; r < 16; ++r) { p0[r] = keep ? p0[r] : NEG; p1[r] = keep ? p1[r] : NEG; }
}
__device__ __forceinline__ void partialSM(f32x16& p0, f32x16& p1, float& m_reg, float& mn, float& alpha) {
    float pmax = p0[0]; for (int r = 1; r < 16; ++r) pmax = fmaxf(pmax, p0[r]); for (int r = 0; r < 16; ++r) pmax = fmaxf(pmax, p1[r]);
    { auto rr = __builtin_amdgcn_permlane32_swap(__float_as_uint(pmax), __float_as_uint(pmax), false, false);
      pmax = fmaxf(__uint_as_float(rr[0]), __uint_as_float(rr[1])); }
    constexpr float C2 = 1.4426950408889634f * SCALE;
    if (__builtin_expect(__all((pmax - m_reg) * SCALE <= THR), 1)) { mn = m_reg; alpha = 1.f; }
    else { mn = fmaxf(m_reg, pmax); alpha = __builtin_amdgcn_exp2f((m_reg - mn) * C2); m_reg = mn; }
    const float mnL = -mn * C2;
    for (int r = 0; r < 16; ++r) p0[r] = fmaf(p0[r], C2, mnL); for (int r = 0; r < 16; ++r) p1[r] = fmaf(p1[r], C2, mnL);
    for (int r = 0; r < 16; ++r) p0[r] = __builtin_amdgcn_exp2f(p0[r]);
}
__device__ __forceinline__ void finishSM(f32x16& p0, f32x16& p1, float alpha, float& l_reg, bf16x8& pa0, bf16x8& pa1, bf16x8& pa2, bf16x8& pa3) {
    for (int r = 0; r < 16; ++r) p1[r] = __builtin_amdgcn_exp2f(p1[r]);
    float ps = 0; for (int r = 0; r < 16; ++r) ps += p0[r]; for (int r = 0; r < 16; ++r) ps += p1[r];
    { auto rr = __builtin_amdgcn_permlane32_swap(__float_as_uint(ps), __float_as_uint(ps), false, false);
      ps = __uint_as_float(rr[0]) + __uint_as_float(rr[1]); }
    l_reg = l_reg * alpha + ps;
#define PK4(P, B_, OUT) do { unsigned a0 = cvtpk(P[B_+0], P[B_+1]), a1 = cvtpk(P[B_+2], P[B_+3]);                          \
        unsigned b0 = cvtpk(P[B_+4], P[B_+5]), b1 = cvtpk(P[B_+6], P[B_+7]);                                             \
        auto r0 = __builtin_amdgcn_permlane32_swap(a0, b0, false, false); auto r1 = __builtin_amdgcn_permlane32_swap(a1, b1, false, false); \
        u32x4 w = {r0[0], r1[0], r0[1], r1[1]}; OUT = *reinterpret_cast<bf16x8*>(&w); } while (0)
    PK4(p0, 0, pa0); PK4(p0, 8, pa1); PK4(p1, 0, pa2); PK4(p1, 8, pa3);
#undef PK4
}
template <int KB>
__device__ __forceinline__ void qkt(f32x16& p0, f32x16& p1, const char* K_lds, int r32, int hi, const bf16x8* qr) {
    p0 = f32x16{}; p1 = f32x16{};
    const char* kb[4];
#pragma unroll
    for (int dd = 0; dd < 4; ++dd) kb[dd] = K_lds + KB * SHM_K + KSWZ(r32, (dd * 16 + hi * 8) * 2);
#pragma unroll
    for (int d0 = 0; d0 < 8; ++d0) { const char* a = kb[d0 & 3] + (d0 >> 2) * 128;
        bf16x8 b0 = *reinterpret_cast<const bf16x8*>(a);
        bf16x8 b1 = *reinterpret_cast<const bf16x8*>(a + 32 * 256);
        p0 = __builtin_amdgcn_mfma_f32_32x32x16_bf16(b0, qr[d0], p0, 0, 0, 0);
        p1 = __builtin_amdgcn_mfma_f32_32x32x16_bf16(b1, qr[d0], p1, 0, 0, 0); }
}
template <int VB>
__device__ __forceinline__ void pv_tile(f32x16* o, int vb0, bf16x8 pa0, bf16x8 pa1, bf16x8 pa2, bf16x8 pa3) {
#define TRRD(dst, off) asm volatile("ds_read_b64_tr_b16 %0, %1 offset:%2" : "=&v"(dst) : "v"(vb0), "i"(off) : "memory")
#define PV_D0(d0) do { s16x4 l0, l1, l2, l3, h0, h1, h2, h3; constexpr int b_ = VB * SHM_V + v_rd_off(d0, 0, 0);     \
        TRRD(l0, b_); TRRD(h0, b_ + 2048); TRRD(l1, b_ + 4096); TRRD(h1, b_ + 6144); TRRD(l2, b_ + 8192); TRRD(h2, b_ + 10240); TRRD(l3, b_ + 12288); TRRD(h3, b_ + 14336); \
        asm volatile("s_waitcnt lgkmcnt(0)" ::: "memory"); SBAR();                 \
        o[d0] = __builtin_amdgcn_mfma_f32_32x32x16_bf16(pa0, (bf16x8){l0[0], l0[1], l0[2], l0[3], h0[0], h0[1], h0[2], h0[3]}, o[d0], 0, 0, 0);   \
        o[d0] = __builtin_amdgcn_mfma_f32_32x32x16_bf16(pa1, (bf16x8){l1[0], l1[1], l1[2], l1[3], h1[0], h1[1], h1[2], h1[3]}, o[d0], 0, 0, 0);   \
        o[d0] = __builtin_amdgcn_mfma_f32_32x32x16_bf16(pa2, (bf16x8){l2[0], l2[1], l2[2], l2[3], h2[0], h2[1], h2[2], h2[3]}, o[d0], 0, 0, 0);   \
        o[d0] = __builtin_amdgcn_mfma_f32_32x32x16_bf16(pa3, (bf16x8){l3[0], l3[1], l3[2], l3[3], h3[0], h3[1], h3[2], h3[3]}, o[d0], 0, 0, 0); } while (0)
    PV_D0(0); PV_D0(1); PV_D0(2); PV_D0(3);
#undef PV_D0
#undef TRRD
}

struct BlockRef { const abf* Q; const abf* K; const abf* V; abf* O; const float* kmean; int P0; };
struct Seam { bf16x8 qr[8]; bf16x8 st_v0, st_v1, st_k0, st_k1; };
#define ROW(p, k0, rr) ((p) + (size_t)((k0) + (rr)) * KVP + sc)
#define VMW() asm volatile("s_waitcnt vmcnt(0)" ::: "memory")
#define VMWN(n) asm volatile("s_waitcnt vmcnt(%0)" :: "i"(n) : "memory")
#define SLOAD_H(Kp, Vp, k0) do { S.st_v0 = load8(ROW(Vp, k0, sr)); S.st_v1 = load8(ROW(Vp, k0, 32 + sr));              \
                         S.st_k0 = load8(ROW(Kp, k0, sr)); S.st_k1 = load8(ROW(Kp, k0, 32 + sr)); } while (0)
#define SWRITE_HK(bf) do { *(bf16x8*)(K_lds + (bf) * SHM_K + kws) = S.st_k0; *(bf16x8*)(K_lds + (bf) * SHM_K + kws + 32 * 256) = S.st_k1; } while (0)
#define SWRITE_HV(bf) do { *(bf16x8*)(V_lds + (bf) * SHM_V + vst0) = S.st_v0; *(bf16x8*)(V_lds + (bf) * SHM_V + vst1) = S.st_v1; } while (0)
#define SWRITE_H(bf) do { SWRITE_HV(bf); SWRITE_HK(bf); } while (0)
__device__ __forceinline__ void moba_prime(const BlockRef& cur, char* lds, Seam& S, int tid) {
    const int wid = __builtin_amdgcn_readfirstlane(tid >> 6), lane = tid & 63, r32 = lane & 31, hi = lane >> 5;
    const int sr = tid >> 4, sc = (tid & 15) * 8, kws = KSWZ(sr, sc * 2); char* K_lds = lds + 2 * SHM_V;
#pragma unroll
    for (int d0 = 0; d0 < 8; ++d0) S.qr[d0] = load8(cur.Q + (size_t)(wid * QBLK + r32) * KVP + d0 * 16 + hi * 8);
    SLOAD_H(cur.K, cur.V, 0); VMW(); SWRITE_HK(0);
    __syncthreads();
}
__device__ __forceinline__ void moba_block(const BlockRef& cur, const BlockRef& nxt, char* lds, Seam& S, int tid) {
    const int wid = __builtin_amdgcn_readfirstlane(tid >> 6), lane = tid & 63, r32 = lane & 31, hi = lane >> 5;
    const int qb = cur.P0 >> 8;
    const int NT = (cur.P0 + QB) / KVBLK;
    const int qlo = cur.P0 + wid * QBLK, qm = qlo + r32 - 4 * hi;
    char* V_lds = lds; char* K_lds = lds + 2 * SHM_V;
    float* wsl = (float*)(lds + 2 * SHM_V + 2 * SHM_K) + wid * 64; float* li_l = wsl, * al_l = wsl + 32;
    unsigned sel = (1u << qb) - 1u;
    if (qb > 3) {
        float gate[7];
#pragma unroll
        for (int n = 0; n < 7; ++n) { float g = 0.f;
            if (n < qb) {
#pragma unroll
                for (int d0 = 0; d0 < 8; ++d0) { const float* km = cur.kmean + n * 128 + d0 * 16 + hi * 8; const f32x4 k0 = *(const f32x4*)km, k1 = *(const f32x4*)(km + 4); const bf16x8 q = S.qr[d0];
                    g += __uint_as_float((unsigned)(unsigned short)q[0] << 16) * k0[0] + __uint_as_float((unsigned)(unsigned short)q[1] << 16) * k0[1] + __uint_as_float((unsigned)(unsigned short)q[2] << 16) * k0[2] + __uint_as_float((unsigned)(unsigned short)q[3] << 16) * k0[3];
                    g += __uint_as_float((unsigned)(unsigned short)q[4] << 16) * k1[0] + __uint_as_float((unsigned)(unsigned short)q[5] << 16) * k1[1] + __uint_as_float((unsigned)(unsigned short)q[6] << 16) * k1[2] + __uint_as_float((unsigned)(unsigned short)q[7] << 16) * k1[3]; } }
            gate[n] = g + __shfl_xor(g, 32); }
        sel = 0u;
#pragma unroll
        for (int pick = 0; pick < 3; ++pick) { float best = -__builtin_inff(); int bi = -1;
#pragma unroll
            for (int n = 0; n < 7; ++n) { const bool ok = (n < qb) && !((sel >> n) & 1u) && (gate[n] > best); if (ok) { best = gate[n]; bi = n; } }
            if (bi >= 0) sel |= 1u << bi; }
    }
    float m_reg = -1e30f, l_reg = 0; f32x16 o[4] = {};
    const int sr = tid >> 4, sc = (tid & 15) * 8, vst0 = v_st(sr, sc), vst1 = v_st(32 + sr, sc), kws = KSWZ(sr, sc * 2);
    const int vb0 = (int)(uintptr_t)V_lds + v_rd_base(lane);
    const abf* Kh = cur.K; const abf* Vh = cur.V;
#define RESC(a) do { if (__any((a) < 1.f)) { if (hi == 0) al_l[r32] = (a); asm volatile("s_waitcnt lgkmcnt(0)" ::: "memory");              \
                     for (int d_ = 0; d_ < 4; ++d_) for (int r = 0; r < 16; ++r) o[d_][r] *= al_l[crow(r, hi)]; } } while (0)
#define KBASE(t) ((t) * KVBLK)
#define MASKT(P0_, P1_, t) do { const int kb_ = KBASE(t); const int nb_ = kb_ >> 8; \
        if (nb_ < qb) { const bool keep_ = (sel >> nb_) & 1u; if (!__all(keep_)) kill_tile(P0_, P1_, keep_); } \
        else if (kb_ + KVBLK - 1 > qlo) mask_tile(P0_, P1_, qm - kb_); } while (0)
    constexpr int NQL = 8;
#define SEAM_K0() do { VMWN(NQL); SWRITE_HK(0); SBAR(); } while (0)
    f32x16 pA0, pA1, pB0, pB1; float mnA, mnB, alA, alB; bf16x8 pa0, pa1, pa2, pa3;
    SWRITE_HV(0); SBAR();
    if (NT > 1) { SLOAD_H(Kh, Vh, KBASE(1)); }
    SBAR(); qkt<0>(pA0, pA1, K_lds, r32, hi, S.qr);
    MASKT(pA0, pA1, 0); partialSM(pA0, pA1, m_reg, mnA, alA);
    if (NT > 1) { VMW(); SWRITE_H(1); }
    __syncthreads();
#define HALF_STEP(PX0, PX1, mnX, alX, PY0, PY1, alY, t, KB, VB, SB) do {                                                      \
        SBAR(); qkt<KB>(PX0, PX1, K_lds, r32, hi, S.qr);                                                                       \
        finishSM(PY0, PY1, alY, l_reg, pa0, pa1, pa2, pa3); SBAR();                                                           \
        if ((t) + 1 < NT) { SLOAD_H(Kh, Vh, KBASE((t) + 1)); SBAR(); }                                                        \
        pv_tile<VB>(o, vb0, pa0, pa1, pa2, pa3); MASKT(PX0, PX1, (t)); partialSM(PX0, PX1, m_reg, mnX, alX);                   \
        __syncthreads();                                                                                                      \
        if ((t) + 1 < NT) { VMW(); SWRITE_H(SB); }                                                                            \
        RESC(alX); __syncthreads(); } while (0)
    for (int t = 1; t + 1 < NT; t += 2) {
        HALF_STEP(pB0, pB1, mnB, alB, pA0, pA1, alA, t, 1, 0, 0);
        HALF_STEP(pA0, pA1, mnA, alA, pB0, pB1, alB, t + 1, 0, 1, 1);
    }
    const bool even = (NT & 1) == 0;
    if (even) { SBAR(); qkt<1>(pB0, pB1, K_lds, r32, hi, S.qr); SBAR(); }
    SLOAD_H(nxt.K, nxt.V, 0); SBAR();
#pragma unroll
    for (int d0 = 0; d0 < 8; ++d0) S.qr[d0] = load8(nxt.Q + (size_t)(wid * QBLK + r32) * KVP + d0 * 16 + hi * 8);
    SBAR();
    finishSM(pA0, pA1, alA, l_reg, pa0, pa1, pa2, pa3); SBAR();
    pv_tile<0>(o, vb0, pa0, pa1, pa2, pa3);
    if (even) { MASKT(pB0, pB1, NT - 1); partialSM(pB0, pB1, m_reg, mnB, alB); __syncthreads(); RESC(alB);
        finishSM(pB0, pB1, alB, l_reg, pa0, pa1, pa2, pa3); SBAR(); pv_tile<1>(o, vb0, pa0, pa1, pa2, pa3); }
    SBAR(); SEAM_K0();
    if (hi == 0) li_l[r32] = l_reg; asm volatile("s_waitcnt lgkmcnt(0)" ::: "memory");
    float rli[16];
#pragma unroll
    for (int r = 0; r < 16; ++r) rli[r] = __builtin_amdgcn_rcpf(li_l[crow(r, hi)]);
    abf* Ow = cur.O + (size_t)(wid * QBLK) * OP;
#pragma unroll
    for (int r = 0; r < 16; ++r) { const int orow = crow(r, hi);
#pragma unroll
        for (int d0 = 0; d0 < 4; ++d0) { const float v = o[d0][r] * rli[r];
            const float vn = __shfl_xor(v, 1);
            if ((r32 & 1) == 0) *(unsigned*)(Ow + (size_t)orow * OP + d0 * 32 + r32) = cvtpk(v, vn); } }
    __syncthreads();
#undef RESC
#undef KBASE
#undef MASKT
#undef SEAM_K0
#undef HALF_STEP
}
#undef ROW
#undef VMW
#undef VMWN
#undef SLOAD_H
#undef SWRITE_HK
#undef SWRITE_HV
#undef SWRITE_H
#undef KSWZ
#undef SBAR
}

namespace ssd {
#define SLAS __attribute__((address_space(3)))
typedef unsigned short sbf;
typedef short bf16x8 __attribute__((ext_vector_type(8)));
typedef short s16x4 __attribute__((ext_vector_type(4)));
typedef float f32x16 __attribute__((ext_vector_type(16)));
typedef float f32x4 __attribute__((ext_vector_type(4)));
typedef float f32x2 __attribute__((ext_vector_type(2)));
typedef unsigned u32x4 __attribute__((ext_vector_type(4)));
typedef unsigned u32x2 __attribute__((ext_vector_type(2)));
typedef __bf16 bf16x2v __attribute__((ext_vector_type(2)));
constexpr int LCH = 64, NCH = 32;
constexpr int PROJP = 5888;
constexpr int C_Z = 3072, C_X = 4096, C_DT = 5632;
constexpr int XP = 1040, BP = 272;
constexpr int OFF_X = 0, OFF_B = 64 * XP, OFF_C = OFF_B + 64 * BP, OFF_W = OFF_C + 64 * BP, SSD_LDS_BYTES = OFF_W + 8 * 3 * 64 * 4;
__device__ __forceinline__ unsigned pkbf(float a, float b) { const f32x2 v = {a, b}; const bf16x2v r = __builtin_convertvector(v, bf16x2v); return __builtin_bit_cast(unsigned, r); }
__device__ __forceinline__ float bff(unsigned short b) { return __uint_as_float(((unsigned)b) << 16); }
__device__ __forceinline__ int crow(int r, int hi) { return (r & 3) + 8 * (r >> 2) + 4 * hi; }
__device__ __forceinline__ float silu(float v) { return v / (1.f + __expf(-v)); }
__device__ __forceinline__ float softplus(float v) { return fmaxf(v, 0.f) + log1pf(__expf(-fabsf(v))); }
#define MFMA32(a, b, c) __builtin_amdgcn_mfma_f32_32x32x16_bf16((a), (b), (c), 0, 0, 0)
__device__ __forceinline__ bf16x8 tr_frag(SLAS const unsigned char* img, int pitch, int rowA, int rowB, int j0, int lane) {
    const int i16 = lane & 15, q = i16 >> 2, p4 = i16 & 3, col = j0 + 16 * ((lane >> 4) & 1) + 4 * p4;
    const s16x4 lo = __builtin_amdgcn_ds_read_tr16_b64_v4i16((SLAS s16x4*)(img + (rowA + q) * pitch + 2 * col));
    const s16x4 hi = __builtin_amdgcn_ds_read_tr16_b64_v4i16((SLAS s16x4*)(img + (rowB + q) * pitch + 2 * col));
    return __builtin_shufflevector(lo, hi, 0, 1, 2, 3, 4, 5, 6, 7);
}
__device__ __forceinline__ bf16x8 row_frag(SLAS const unsigned char* img, int pitch, int row0, int kbase, int lane) {
    return *(SLAS const bf16x8*)(img + (row0 + (lane & 31)) * pitch + 2 * (kbase + 8 * (lane >> 5)));
}
template <int R>
__device__ __forceinline__ void conv_rows(const sbf* prow0, int spos0, int r0, int ch, const float* cw, const float* cb, float (&out)[R][8]) {
    u32x4 raw[R + 3];
#pragma unroll
    for (int i = 0; i < R + 3; ++i) { const int r = r0 - 3 + i; raw[i] = (spos0 + r >= 0) ? *(const u32x4*)(prow0 + (ptrdiff_t)r * PROJP + C_X + ch) : (u32x4){0u, 0u, 0u, 0u}; }
    f32x4 w[4][2]; f32x4 bias[2];
#pragma unroll
    for (int k = 0; k < 4; ++k) { w[k][0] = *(const f32x4*)(cw + k * 1536 + ch); w[k][1] = *(const f32x4*)(cw + k * 1536 + ch + 4); }
    bias[0] = *(const f32x4*)(cb + ch); bias[1] = *(const f32x4*)(cb + ch + 4);
#pragma unroll
    for (int i = 0; i < R; ++i)
#pragma unroll
        for (int c = 0; c < 8; ++c) { float a = bias[c >> 2][c & 3];
#pragma unroll
            for (int k = 0; k < 4; ++k) { const unsigned wd = raw[i + k][c >> 1]; const float xv = (c & 1) ? __uint_as_float(wd & 0xffff0000u) : __uint_as_float(wd << 16); a += w[k][c >> 2][c & 3] * xv; }
            out[i][c] = silu(a); }
}
__device__ __forceinline__ void head_dt(const sbf* prow0, int h, float dtb, float A, int lane, float& dt, float& acs, float& acs_last) {
    dt = softplus(bff(prow0[(size_t)lane * PROJP + C_DT + h]) + dtb);
    float s = A * dt;
#pragma unroll
    for (int o = 1; o < 64; o <<= 1) { const float t = __shfl_up(s, o); if (lane >= o) s += t; }
    acs = s; acs_last = __shfl(s, 63);
}

struct Unit { const sbf* prow0; int spos0; int g; };

__device__ __forceinline__ void chunk_state_unit(const Unit& U, SLAS unsigned char* lds, const float* cw, const float* cb, const float* dt_bias, const float* a_log, sbf* cs_out  , float* dec_out  , int tid) {
    const int lane = tid & 63, e = __builtin_amdgcn_readfirstlane(tid >> 6), h = U.g * 8 + e, hi = lane >> 5;
    SLAS float* wv = (SLAS float*)(lds + OFF_W) + e * 192;
    { float dt, acs, al; head_dt(U.prow0, h, dt_bias[h], -__expf(a_log[h]), lane, dt, acs, al);
      wv[lane] = dt * __expf(al - acs); if (lane == 0) dec_out[e] = __expf(al); }
    __syncthreads();
    { const int cg = tid & 63, rr = tid >> 6, ch = U.g * 512 + cg * 8;
      SLAS const float* wh = (SLAS const float*)(lds + OFF_W) + (cg >> 3) * 192;
#pragma unroll 1
      for (int hf = 0; hf < 2; ++hf) { float o[4][8];
          conv_rows<4>(U.prow0, U.spos0, rr * 8 + hf * 4, ch, cw, cb, o);
#pragma unroll
          for (int i = 0; i < 4; ++i) { const float w = wh[rr * 8 + hf * 4 + i]; u32x4 v; v.x = pkbf(o[i][0] * w, o[i][1] * w); v.y = pkbf(o[i][2] * w, o[i][3] * w); v.z = pkbf(o[i][4] * w, o[i][5] * w); v.w = pkbf(o[i][6] * w, o[i][7] * w);
              *(SLAS u32x4*)(lds + OFF_X + (rr * 8 + hf * 4 + i) * XP + cg * 16) = v; } } }
    { const int cg = tid & 15, rr = tid >> 4, ch = 1024 + U.g * 128 + cg * 8; float o[2][8];
      conv_rows<2>(U.prow0, U.spos0, rr * 2, ch, cw, cb, o);
#pragma unroll
      for (int i = 0; i < 2; ++i) { u32x4 v; v.x = pkbf(o[i][0], o[i][1]); v.y = pkbf(o[i][2], o[i][3]); v.z = pkbf(o[i][4], o[i][5]); v.w = pkbf(o[i][6], o[i][7]);
          *(SLAS u32x4*)(lds + OFF_B + (rr * 2 + i) * BP + cg * 16) = v; } }
    __syncthreads();
    f32x16 acc[4][2];
#pragma unroll
    for (int nb = 0; nb < 4; ++nb)
#pragma unroll
        for (int pb = 0; pb < 2; ++pb) acc[nb][pb] = f32x16{};
#pragma unroll
    for (int s = 0; s < 4; ++s) { const int rA = 16 * s + 8 * hi;
        bf16x8 bx[2];
#pragma unroll
        for (int pb = 0; pb < 2; ++pb) bx[pb] = tr_frag(lds + OFF_X, XP, rA, rA + 4, e * 64 + 32 * pb, lane);
#pragma unroll
        for (int nb = 0; nb < 4; ++nb) { const bf16x8 a = tr_frag(lds + OFF_B, BP, rA, rA + 4, 32 * nb, lane);
#pragma unroll
            for (int pb = 0; pb < 2; ++pb) acc[nb][pb] = MFMA32(a, bx[pb], acc[nb][pb]); } }
    sbf* co = cs_out + (size_t)e * 8192;
#pragma unroll
    for (int nb = 0; nb < 4; ++nb)
#pragma unroll
        for (int pb = 0; pb < 2; ++pb) { const int p = 32 * pb + (lane & 31);
#pragma unroll
            for (int gq = 0; gq < 4; ++gq) { u32x2 v; v.x = pkbf(acc[nb][pb][4 * gq], acc[nb][pb][4 * gq + 1]); v.y = pkbf(acc[nb][pb][4 * gq + 2], acc[nb][pb][4 * gq + 3]);
                *(u32x2*)(co + p * 128 + 32 * nb + 8 * gq + 4 * hi) = v; } }
    __syncthreads();
}

__device__ __forceinline__ void chunk_out_unit(const Unit& U, SLAS unsigned char* lds, const float* cw, const float* cb, const float* dt_bias, const float* a_log, const float* d_skip, const float* gain  ,
                                               const sbf* prev  , sbf* mix_row0  , int mix_pitch, float eps, int tid) {
    const int lane = tid & 63, e = __builtin_amdgcn_readfirstlane(tid >> 6), h = U.g * 8 + e, hi = lane >> 5, l31 = lane & 31;
    SLAS float* dtv = (SLAS float*)(lds + OFF_W) + e * 192; SLAS float* acv = dtv + 64; SLAS float* eav = dtv + 128;
    { float dt, acs, al; head_dt(U.prow0, h, dt_bias[h], -__expf(a_log[h]), lane, dt, acs, al); dtv[lane] = dt; acv[lane] = acs; eav[lane] = __expf(acs); }
    { const int cg = tid & 63, rr = tid >> 6, ch = U.g * 512 + cg * 8;
#pragma unroll 1
      for (int hf = 0; hf < 2; ++hf) { float o[4][8];
          conv_rows<4>(U.prow0, U.spos0, rr * 8 + hf * 4, ch, cw, cb, o);
#pragma unroll
          for (int i = 0; i < 4; ++i) { u32x4 v; v.x = pkbf(o[i][0], o[i][1]); v.y = pkbf(o[i][2], o[i][3]); v.z = pkbf(o[i][4], o[i][5]); v.w = pkbf(o[i][6], o[i][7]);
              *(SLAS u32x4*)(lds + OFF_X + (rr * 8 + hf * 4 + i) * XP + cg * 16) = v; } } }
    { const int cg = tid & 31, rr = tid >> 5, ch = 1024 + (cg >> 4) * 256 + U.g * 128 + (cg & 15) * 8; float o[4][8];
      conv_rows<4>(U.prow0, U.spos0, rr * 4, ch, cw, cb, o);
#pragma unroll
      for (int i = 0; i < 4; ++i) { u32x4 v; v.x = pkbf(o[i][0], o[i][1]); v.y = pkbf(o[i][2], o[i][3]); v.z = pkbf(o[i][4], o[i][5]); v.w = pkbf(o[i][6], o[i][7]);
          *(SLAS u32x4*)(lds + ((cg >> 4) ? OFF_C : OFF_B) + (rr * 4 + i) * BP + (cg & 15) * 16) = v; } }
    __syncthreads();
    f32x16 acc[2][2];
#pragma unroll
    for (int lb = 0; lb < 2; ++lb)
#pragma unroll
        for (int pb = 0; pb < 2; ++pb) acc[lb][pb] = f32x16{};
    const sbf* pv = prev + (size_t)e * 8192;
#pragma unroll
    for (int ks = 0; ks < 8; ++ks) { bf16x8 pf[2], cf[2];
#pragma unroll
        for (int pb = 0; pb < 2; ++pb) pf[pb] = *(const bf16x8*)(pv + (32 * pb + l31) * 128 + 16 * ks + 8 * hi);
#pragma unroll
        for (int lb = 0; lb < 2; ++lb) cf[lb] = row_frag(lds + OFF_C, BP, 32 * lb, 16 * ks, lane);
#pragma unroll
        for (int lb = 0; lb < 2; ++lb)
#pragma unroll
            for (int pb = 0; pb < 2; ++pb) acc[lb][pb] = MFMA32(cf[lb], pf[pb], acc[lb][pb]); }
#pragma unroll
    for (int lb = 0; lb < 2; ++lb)
#pragma unroll
        for (int r = 0; r < 16; ++r) { const float f = eav[32 * lb + crow(r, hi)]; acc[lb][0][r] *= f; acc[lb][1][r] *= f; }
    const float Dh = d_skip[h];
#pragma unroll
    for (int tile = 0; tile < 3; ++tile) { const int sb = tile >> 1, lb = (tile + 1) >> 1;
        f32x16 X = f32x16{};
#pragma unroll
        for (int ks = 0; ks < 8; ++ks) X = MFMA32(row_frag(lds + OFF_B, BP, 32 * sb, 16 * ks, lane), row_frag(lds + OFF_C, BP, 32 * lb, 16 * ks, lane), X);
        const int l = 32 * lb + l31; const float al = acv[l];
#pragma unroll
        for (int r = 0; r < 16; ++r) { const int s = 32 * sb + crow(r, hi); const float v = X[r] * __expf(al - acv[s]) * dtv[s];
            X[r] = (sb != lb || s <= l) ? v : 0.f; if (sb == lb && s == l) X[r] += Dh; }
#pragma unroll
        for (int k2 = 0; k2 < 2; ++k2) { u32x4 w; w.x = pkbf(X[8 * k2], X[8 * k2 + 1]); w.y = pkbf(X[8 * k2 + 2], X[8 * k2 + 3]); w.z = pkbf(X[8 * k2 + 4], X[8 * k2 + 5]); w.w = pkbf(X[8 * k2 + 6], X[8 * k2 + 7]);
            const bf16x8 xa = __builtin_bit_cast(bf16x8, w); const int rA = 32 * sb + 16 * k2 + 4 * hi;
#pragma unroll
            for (int pb = 0; pb < 2; ++pb) acc[lb][pb] = MFMA32(xa, tr_frag(lds + OFF_X, XP, rA, rA + 8, e * 64 + 32 * pb, lane), acc[lb][pb]); } }
#pragma unroll
    for (int lb = 0; lb < 2; ++lb)
#pragma unroll
        for (int pb = 0; pb < 2; ++pb)
#pragma unroll
            for (int r = 0; r < 16; ++r) { const unsigned w = pkbf(acc[lb][pb][r], 0.f); *(SLAS unsigned short*)(lds + OFF_X + (32 * lb + crow(r, hi)) * XP + (e * 64 + 32 * pb + l31) * 2) = (unsigned short)(w & 0xffffu); }
    __syncthreads();
    { const int l = tid >> 3, seg = tid & 7; float v[64]; float ss = 0.f;
      const sbf* zrow = U.prow0 + (size_t)l * PROJP + C_Z + U.g * 512 + seg * 64;
#pragma unroll
      for (int c8 = 0; c8 < 8; ++c8) { const u32x4 yw = *(SLAS const u32x4*)(lds + OFF_X + l * XP + (seg * 64 + c8 * 8) * 2); const u32x4 zw = *(const u32x4*)(zrow + c8 * 8);
#pragma unroll
          for (int q = 0; q < 4; ++q) { const float y0 = __uint_as_float(yw[q] << 16), y1 = __uint_as_float(yw[q] & 0xffff0000u), z0 = __uint_as_float(zw[q] << 16), z1 = __uint_as_float(zw[q] & 0xffff0000u);
              const float a = y0 * silu(z0), b = y1 * silu(z1); v[c8 * 8 + 2 * q] = a; v[c8 * 8 + 2 * q + 1] = b; ss += a * a + b * b; } }
      ss += __shfl_xor(ss, 1); ss += __shfl_xor(ss, 2); ss += __shfl_xor(ss, 4);
      const float inv = 1.0f / sqrtf(ss * (1.f / 512.f) + eps); const float* gp = gain + U.g * 512 + seg * 64; sbf* orow = mix_row0 + (size_t)l * mix_pitch + seg * 64;
#pragma unroll
      for (int c8 = 0; c8 < 8; ++c8) { const f32x4 g0 = *(const f32x4*)(gp + c8 * 8), g1 = *(const f32x4*)(gp + c8 * 8 + 4); u32x4 w;
          w.x = pkbf(v[c8 * 8] * inv * g0[0], v[c8 * 8 + 1] * inv * g0[1]); w.y = pkbf(v[c8 * 8 + 2] * inv * g0[2], v[c8 * 8 + 3] * inv * g0[3]);
          w.z = pkbf(v[c8 * 8 + 4] * inv * g1[0], v[c8 * 8 + 5] * inv * g1[1]); w.w = pkbf(v[c8 * 8 + 6] * inv * g1[2], v[c8 * 8 + 7] * inv * g1[3]);
          *(u32x4*)(orow + c8 * 8) = w; } }
    __syncthreads();
}
#undef MFMA32
}


constexpr int NWAVES = 8;
constexpr int BATCH = 4, SEQ = 2048, DM = 2048, MTOK = BATCH * SEQ, DEPTH = 4;
constexpr int AW = 1024, NH = 8, HD = 128, MOBA_BLK = 256, NBLK = SEQ / MOBA_BLK;
constexpr int SW = 1024, SH = 16, SP = 64, SN = 128, CONVD = 1536;
constexpr int IN_DIM = 5648, NPROJ = 5888, DFF = 8192;
constexpr int CQ = 0, CK = 1024, CV = 2048, CZ = 3072, CX = 4096, CBm = 5120, CCm = 5376, CDT = 5632;
constexpr float NORM_EPS = 1e-6f;
constexpr float ATT_SCALE = 0.08838834764831845f;

constexpr size_t MiB = 1u << 20;
constexpr size_t WS_CTL = 0, CTL_ZERO_BYTES = 1 * MiB;
constexpr size_t WS_ROPE = 1 * MiB;
constexpr size_t WS_INVA = 2 * MiB, WS_INVB = 2 * MiB + 64 * 1024;
constexpr size_t WS_KMEAN = 2 * MiB + 128 * 1024;
constexpr size_t WS_DT = 3 * MiB;
constexpr size_t WS_WIN = 4 * MiB, WIN_BYTES = (size_t)NPROJ * DM * 2;
constexpr size_t WS_WOUT = 96 * MiB, WOUT_BYTES = (size_t)DM * DM * 2;
constexpr size_t WS_WUP = 128 * MiB, WUP_BYTES = (size_t)DFF * DM * 2;
constexpr size_t WS_WDN = 256 * MiB, WDN_BYTES = (size_t)DM * DFF * 2;
constexpr size_t WS_XB = 384 * MiB;
constexpr size_t WS_PROJ = 416 * MiB;
constexpr size_t WS_MIX = 508 * MiB;
constexpr size_t WS_Y = 540 * MiB;
constexpr size_t WS_HID = 604 * MiB;
constexpr size_t WS_XBC = 732 * MiB;
constexpr size_t WS_YS = 780 * MiB;
constexpr size_t WS_CS = 812 * MiB;
constexpr size_t WS_DEC = 3 * MiB + 512 * 1024;
constexpr size_t WS_END = 844 * MiB;
static_assert(WS_WIN + 4 * WIN_BYTES <= WS_WOUT && WS_PROJ + (size_t)MTOK * NPROJ * 2 <= WS_MIX, "ws map");
constexpr int CW_BAR = 4096;

constexpr int RING_BYTES = 131072, LDSCTL_OFF = RING_BYTES, MISC_OFF = LDSCTL_OFF + 320, LDS_BYTES = 147456;

typedef unsigned long long u64;
__device__ __forceinline__ float bf2f(bf16 b) { return __uint_as_float(((unsigned)b) << 16); }
__device__ __forceinline__ float wave_sum(float v) {
#pragma unroll
    for (int o = 1; o < 64; o <<= 1) v += __shfl_xor(v, o);
    return v;
}
__device__ __forceinline__ float wave_max(float v) {
#pragma unroll
    for (int o = 1; o < 64; o <<= 1) v = fmaxf(v, __shfl_xor(v, o));
    return v;
}
__device__ __forceinline__ float silu_f(float v) { return v / (1.f + __expf(-v)); }
__device__ __forceinline__ float softplus_f(float v) { return fmaxf(v, 0.f) + log1pf(__expf(-fabsf(v))); }

__device__ __forceinline__ void transpose_item(const float* W, int ldw, int ncols, int K, const float* gain, bf16* WT, LAS float* scr, int item, int lane) {
    const int nblk = ncols / 32, kb = item / nblk, nb = item % nblk, k0 = 64 * kb, n0 = 32 * nb;
#pragma unroll 8
    for (int i = 0; i < 32; ++i) { const int kk = 2 * i + (lane >> 5); float v = W[(size_t)(k0 + kk) * ldw + n0 + (lane & 31)]; if (gain) v *= gain[k0 + kk]; scr[kk * 33 + (lane & 31)] = v; }
    LDS_WAIT(); asm volatile("" ::: "memory");
    const int c = lane & 7;
#pragma unroll
    for (int j = 0; j < 4; ++j) { const int n = (lane >> 3) + 8 * j; const LAS float* s = scr + (8 * c) * 33 + n;
        v4u o; o.x = pk2(s[0 * 33], s[1 * 33]); o.y = pk2(s[2 * 33], s[3 * 33]); o.z = pk2(s[4 * 33], s[5 * 33]); o.w = pk2(s[6 * 33], s[7 * 33]);
        *(GAS v4u*)(WT + (size_t)(n0 + n) * K + k0 + 8 * c) = o; }
    LDS_WAIT(); asm volatile("" ::: "memory");
}

__device__ __forceinline__ void row_update(const float* xrow, const float* yrow, const float* g, float* xo, bf16* xb, float* inv, int lane) {
    f32x4 v[8];
#pragma unroll
    for (int j = 0; j < 8; ++j) v[j] = ((const GAS f32x4*)xrow)[lane + 64 * j];
    if (yrow) {
        f32x4 y[8]; float s = 0.f;
#pragma unroll
        for (int j = 0; j < 8; ++j) { y[j] = ((const GAS f32x4*)yrow)[lane + 64 * j]; s += (y[j].x * y[j].x + y[j].y * y[j].y) + (y[j].z * y[j].z + y[j].w * y[j].w); }
        const float iy = 1.0f / sqrtf(wave_sum(s) * (1.f / DM) + NORM_EPS);
#pragma unroll
        for (int j = 0; j < 8; ++j) { const f32x4 gg = ((const GAS f32x4*)g)[lane + 64 * j]; v[j] = v[j] + (y[j] * iy) * gg; }
    }
    float s2 = 0.f;
#pragma unroll
    for (int j = 0; j < 8; ++j) { s2 += (v[j].x * v[j].x + v[j].y * v[j].y) + (v[j].z * v[j].z + v[j].w * v[j].w);
        ((GAS f32x4*)xo)[lane + 64 * j] = v[j];
        ((GAS u64*)xb)[lane + 64 * j] = (u64)pk2(v[j].x, v[j].y) | ((u64)pk2(v[j].z, v[j].w) << 32); }
    const float ix = 1.0f / sqrtf(wave_sum(s2) * (1.f / DM) + NORM_EPS);
    if (lane == 0) *inv = ix;
}

__device__ __forceinline__ const void* inp_ptr(LAS unsigned char* lds, int i) {
    const LAS unsigned* p = (const LAS unsigned*)(lds + LDSCTL_OFF + 64 + 8 * i);
    const unsigned lo = __builtin_amdgcn_readfirstlane(p[0]), hi = __builtin_amdgcn_readfirstlane(p[1]);
    return (const void*)(((u64)hi << 32) | lo);
}
__device__ __forceinline__ int hw_tid(int wave) {
    int lane; asm volatile("v_mbcnt_lo_u32_b32 %0, -1, 0\n\tv_mbcnt_hi_u32_b32 %0, -1, %0" : "=v"(lane));
    return wave * 64 + lane;
}
struct Args { const void* in[17]; float* out; unsigned char* ws; int ph_lo, ph_hi; };
constexpr int NPH_LAYER = 9, NPHASES = 1 + DEPTH * NPH_LAYER;

__global__ void __launch_bounds__(NWAVES * 64, 2) fwd_kernel(Args args) {
    extern __shared__ __attribute__((aligned(16))) unsigned char lds_raw[];
    LAS unsigned char* lds = (LAS unsigned char*)lds_raw;
    volatile LAS unsigned* MISC = (volatile LAS unsigned*)(lds + MISC_OFF);
    const int wave0 = __builtin_amdgcn_readfirstlane((int)(threadIdx.x >> 6));
#define HW_TID() hw_tid(wave0)
    const int G = gridDim.x, bx = blockIdx.x;
    const int NGW = G * NWAVES, NGT = G * NWAVES * 64;
#define PHASE_WS unsigned char* ws = ws0; asm volatile("" : "+s"(ws));
#define PHASE_LOCALS PHASE_WS int tid = HW_TID(); asm volatile("" : "+v"(tid)); const int lane = tid & 63, wave = __builtin_amdgcn_readfirstlane(tid >> 6); \
    const int gw = bx * NWAVES + wave, gt = bx * (NWAVES * 64) + tid; (void)gw; (void)gt; (void)lane;
    unsigned char* const ws0 = args.ws;
#define INP(T, i) ((const T*)inp_ptr(lds, (i)))
#define x_in      INP(float, 0)
#define positions INP(int, 1)
#define pre_mix   INP(float, 2)
#define post_mix  INP(float, 3)
#define pre_mlp   INP(float, 4)
#define post_mlp  INP(float, 5)
#define w_in      INP(float, 6)
#define conv_w    INP(float, 7)
#define conv_b    INP(float, 8)
#define dt_bias   INP(float, 9)
#define a_log     INP(float, 10)
#define d_skip    INP(float, 11)
#define attn_norm INP(float, 12)
#define ssd_norm  INP(float, 13)
#define w_out     INP(float, 14)
#define w_up      INP(float, 15)
#define w_down    INP(float, 16)
#define xres      ((float*)inp_ptr(lds, 17))
#define ctl       ((gu32*)(ws + WS_CTL))
#define ROPE      ((float2*)(ws + WS_ROPE))
#define INVA      ((float*)(ws + WS_INVA))
#define INVB      ((float*)(ws + WS_INVB))
#define KMEAN     ((float*)(ws + WS_KMEAN))
#define XB        ((bf16*)(ws + WS_XB))
#define PROJ      ((bf16*)(ws + WS_PROJ))
#define MIX       ((bf16*)(ws + WS_MIX))
#define Y         ((float*)(ws + WS_Y))
#define HID       ((bf16*)(ws + WS_HID))
#define CS        ((bf16*)(ws + WS_CS))
#define DEC       ((float*)(ws + WS_DEC))
    const int tid0 = threadIdx.x;
    for (int u = tid0; u < (LDS_BYTES - LDSCTL_OFF) / 4; u += NWAVES * 64) ((LAS unsigned*)(lds + LDSCTL_OFF))[u] = 0u;
    __syncthreads();
    if (tid0 == 0) { LAS u64* tbl = (LAS u64*)(lds + LDSCTL_OFF + 64);
#pragma unroll
        for (int i = 0; i < 17; ++i) tbl[i] = (u64)args.in[i];
        tbl[17] = (u64)args.out; }
    __syncthreads();
    const int lo = args.ph_lo, hi = args.ph_hi;
    XcdBarrier bar; bar.bar = (unsigned*)(ws0 + WS_CTL) + CW_BAR; bar.x = 0; bar.st = nullptr;
    if (hi - lo > 1) bar = xcd_barrier_post((unsigned*)(ws0 + WS_CTL) + CW_BAR, MISC + 8);
#ifndef PH_MASK
#define PH_MASK 0x3ff
#endif
#define PH_EN(j) ((PH_MASK >> (j)) & 1)
#define IN(k) (lo <= (k) && (k) < hi)
#define BOTH(k) (IN(k) && IN((k) + 1))
#define SEAM(k) do { if (BOTH(k)) xcd_barrier(bar); } while (0)

    if (PH_EN(9) && IN(0)) {
        PHASE_LOCALS
        LAS float* scr = (LAS float*)(lds + wave * 16384);
        constexpr int I_IN = (DM / 64) * (5632 / 32), I_OUT = (DM / 64) * (DM / 32), I_UP = (DM / 64) * (DFF / 32), I_DN = (DFF / 64) * (DM / 32), I_L = I_IN + I_OUT + I_UP + I_DN;
        for (int it = gw; it < DEPTH * I_L; it += NGW) {
            const int l = it / I_L; int r = it % I_L;
            if (r < I_IN) { transpose_item(w_in + (size_t)l * DM * IN_DIM, IN_DIM, 5632, DM, pre_mix + l * DM, (bf16*)(ws + WS_WIN + l * WIN_BYTES), scr, r, lane); continue; } r -= I_IN;
            if (r < I_OUT) { transpose_item(w_out + (size_t)l * DM * DM, DM, DM, DM, nullptr, (bf16*)(ws + WS_WOUT + l * WOUT_BYTES), scr, r, lane); continue; } r -= I_OUT;
            if (r < I_UP) { transpose_item(w_up + (size_t)l * DM * DFF, DFF, DFF, DM, pre_mlp + l * DM, (bf16*)(ws + WS_WUP + l * WUP_BYTES), scr, r, lane); continue; } r -= I_UP;
            transpose_item(w_down + (size_t)l * DFF * DM, DM, DM, DFF, nullptr, (bf16*)(ws + WS_WDN + l * WDN_BYTES), scr, r, lane);
        }
        for (int idx = gt; idx < DEPTH * 256 * DM; idx += NGT) { const int l = idx / (256 * DM), r = idx % (256 * DM), j = r / DM, k = r % DM;
            float v = 0.f; if (j < 16) v = w_in[((size_t)l * DM + k) * IN_DIM + 5632 + j] * pre_mix[l * DM + k];
            ((bf16*)(ws + WS_WIN + l * WIN_BYTES))[(size_t)(5632 + j) * DM + k] = (bf16)f2bf(v); }
        for (int idx = gt; idx < MTOK * 16; idx += NGT) { const int t = idx >> 4, i = idx & 15;
            const float invf = __builtin_amdgcn_exp2f(-(float)i * 1.1832230355827609f);
            const float angf = (float)positions[t] * invf; const double a = (double)angf;
            const double kq = rint(a * 0.63661977236758134); const double yv = fma(-kq, 1.5707963267948966, a) - kq * 6.123233995736766e-17; const int q = ((int)kq) & 3;
            const double y2 = yv * yv;
            const double sn = yv * (1.0 - y2 / 6.0 * (1.0 - y2 / 20.0 * (1.0 - y2 / 42.0 * (1.0 - y2 / 72.0 * (1.0 - y2 / 110.0 * (1.0 - y2 / 156.0))))));
            const double cs = 1.0 - y2 / 2.0 * (1.0 - y2 / 12.0 * (1.0 - y2 / 30.0 * (1.0 - y2 / 56.0 * (1.0 - y2 / 90.0 * (1.0 - y2 / 132.0)))));
            double so, co; if (q == 0) { so = sn; co = cs; } else if (q == 1) { so = cs; co = -sn; } else if (q == 2) { so = -sn; co = -cs; } else { so = -cs; co = sn; }
            ROPE[idx] = make_float2((float)co, (float)so); }
        for (int m = gw; m < MTOK; m += NGW) row_update(x_in + (size_t)m * DM, nullptr, nullptr, xres + (size_t)m * DM, XB + (size_t)m * DM, INVA + m, lane);
        SEAM(0);
    }

    for (int l = 0; l < DEPTH; ++l) {
        const int pb = 1 + NPH_LAYER * l;
        if (PH_EN(0) && IN(pb + 0)) {
            PHASE_WS
            pg8::Gemm g{XB, (const bf16*)(ws + WS_WIN + l * WIN_BYTES), MTOK, NPROJ, DM}; pg8::StaticOrder S; S.init(MTOK, NPROJ, G, bx);
            pg8::EpiRowScaleBf16<0> E{PROJ, NPROJ, INVA};
            pg8::gemm_phase<pg8::EpiRowScaleBf16<0>, pg8::StaticOrder, true, true>(lds, g, S, E, HW_TID());
            SEAM(pb + 0);
        }
        if (PH_EN(1) && IN(pb + 1)) {
            PHASE_LOCALS
            LAS float* part = (LAS float*)lds;
            for (int u = bx; u < BATCH * NH * NBLK; u += G) {
                const int b = u / (NH * NBLK), h = (u / NBLK) % NH, n = u % NBLK;
                const int d = tid & 127, rq = tid >> 7, i16 = d & 15;
                float sum = 0.f;
                for (int i = 0; i < 64; ++i) { const int t = b * SEQ + n * MOBA_BLK + rq * 64 + i;
                    bf16* p = PROJ + (size_t)t * NPROJ + CK + h * HD + d; float v = bf2f(*p);
                    const float o = __shfl_xor(v, 16);
                    if (d < 32) { const float2 cs = ROPE[t * 16 + i16]; const float r = (d < 16) ? (v * cs.x - o * cs.y) : (v * cs.x + o * cs.y); const bf16 rb = (bf16)f2bf(r); *p = rb; v = bf2f(rb); }
                    sum += v; }
                part[rq * 128 + d] = sum;
                __syncthreads();
                if (tid < 128) KMEAN[(size_t)u * 128 + tid] = ((part[tid] + part[128 + tid]) + (part[256 + tid] + part[384 + tid])) * (1.f / 256.f);
                __syncthreads();
            }
            for (int idx = gt; idx < MTOK * NH * 16; idx += NGT) { const int t = idx >> 7, h = (idx >> 4) & 7, i = idx & 15;
                bf16* p = PROJ + (size_t)t * NPROJ + CQ + h * HD + i; const float x1 = bf2f(p[0]), x2 = bf2f(p[16]); const float2 cs = ROPE[t * 16 + i];
                p[0] = (bf16)f2bf(x1 * cs.x - x2 * cs.y); p[16] = (bf16)f2bf(x2 * cs.x + x1 * cs.y); }
            static_assert(ssd::PROJP == NPROJ && ssd::SSD_LDS_BYTES <= RING_BYTES, "ssd body geometry");
            for (int u = bx; u < BATCH * ssd::NCH * 2; u += G) {
                const int b = u >> 6, c = (u >> 1) & 31, g = u & 1;
                ssd::Unit U{PROJ + (size_t)(b * SEQ + c * ssd::LCH) * NPROJ, c * ssd::LCH, g};
                ssd::chunk_state_unit(U, lds, conv_w + (size_t)l * 4 * CONVD, conv_b + (size_t)l * CONVD, dt_bias + l * SH, a_log + l * SH,
                                      CS + ((size_t)((b * ssd::NCH + c) * SH + g * 8)) * 8192, DEC + (b * ssd::NCH + c) * SH + g * 8, tid);
            }
            SEAM(pb + 1);
        }
        if (PH_EN(2) && IN(pb + 2)) {
            PHASE_LOCALS
            for (int it = gt; it < BATCH * SH * 2048; it += NGT) {
                const int bh = it >> 11, off = (it & 2047) * 4, b = bh >> 4, h = bh & 15;
                float r0 = 0.f, r1 = 0.f, r2 = 0.f, r3 = 0.f;
                for (int c = 0; c < ssd::NCH; ++c) { const size_t ci = (size_t)((b * ssd::NCH + c) * SH + h);
                    GAS u64* p = (GAS u64*)(CS + ci * 8192 + off); const u64 w = *p; const float d = DEC[ci];
                    *p = (u64)pk2(r0, r1) | ((u64)pk2(r2, r3) << 32);
                    r0 = r0 * d + __uint_as_float((unsigned)(w & 0xffffu) << 16); r1 = r1 * d + __uint_as_float((unsigned)w & 0xffff0000u);
                    r2 = r2 * d + __uint_as_float((unsigned)((w >> 32) & 0xffffu) << 16); r3 = r3 * d + __uint_as_float((unsigned)(w >> 32) & 0xffff0000u); }
            }
            static_assert(att::KVP == NPROJ && att::OP == DM && att::ATT_LDS_BYTES <= RING_BYTES, "attention body geometry");
            for (int u = bx; u < BATCH * NH * NBLK; u += G) {
                const int xcd = u & 7, k = u >> 3, pair = xcd * 4 + (k >> 3), qb = 7 - (k & 7), b = pair >> 3, h = pair & 7;
                att::BlockRef cur;
                cur.Q = PROJ + (size_t)(b * SEQ + qb * MOBA_BLK) * NPROJ + CQ + h * HD; cur.K = PROJ + (size_t)(b * SEQ) * NPROJ + CK + h * HD; cur.V = PROJ + (size_t)(b * SEQ) * NPROJ + CV + h * HD;
                cur.O = MIX + (size_t)(b * SEQ + qb * MOBA_BLK) * DM + h * HD; cur.kmean = KMEAN + (size_t)((b * NH + h) * NBLK) * 128; cur.P0 = qb * MOBA_BLK;
                att::Seam S;
                att::moba_prime(cur, (char*)lds_raw, S, tid);
                att::moba_block(cur, cur, (char*)lds_raw, S, tid);
            }
            SEAM(pb + 2);
        }
        if (PH_EN(3) && IN(pb + 3)) {
            PHASE_LOCALS
            for (int t = gw; t < MTOK; t += NGW) {
                { bf16* ar = MIX + (size_t)t * DM; float v[16]; float ss = 0.f;
#pragma unroll
                  for (int hlf = 0; hlf < 2; ++hlf) { const v4u w = *(const GAS v4u*)(ar + hlf * 512 + lane * 8); const unsigned w4[4] = {w.x, w.y, w.z, w.w};
#pragma unroll
                      for (int e = 0; e < 4; ++e) { v[hlf * 8 + 2 * e] = __uint_as_float(w4[e] << 16); v[hlf * 8 + 2 * e + 1] = __uint_as_float(w4[e] & 0xffff0000u); } }
#pragma unroll
                  for (int e = 0; e < 16; ++e) ss += v[e] * v[e];
                  const float inv = 1.0f / sqrtf(wave_sum(ss) * (1.f / AW) + NORM_EPS);
#pragma unroll
                  for (int hlf = 0; hlf < 2; ++hlf) { const float* gp = attn_norm + l * AW + hlf * 512 + lane * 8; v4u o;
                      o.x = pk2(v[hlf * 8 + 0] * inv * gp[0], v[hlf * 8 + 1] * inv * gp[1]); o.y = pk2(v[hlf * 8 + 2] * inv * gp[2], v[hlf * 8 + 3] * inv * gp[3]);
                      o.z = pk2(v[hlf * 8 + 4] * inv * gp[4], v[hlf * 8 + 5] * inv * gp[5]); o.w = pk2(v[hlf * 8 + 6] * inv * gp[6], v[hlf * 8 + 7] * inv * gp[7]);
                      *(GAS v4u*)(ar + hlf * 512 + lane * 8) = o; } }
            }
            for (int u = bx; u < BATCH * ssd::NCH * 2; u += G) {
                const int b = u >> 6, c = (u >> 1) & 31, g = u & 1;
                ssd::Unit U{PROJ + (size_t)(b * SEQ + c * ssd::LCH) * NPROJ, c * ssd::LCH, g};
                ssd::chunk_out_unit(U, lds, conv_w + (size_t)l * 4 * CONVD, conv_b + (size_t)l * CONVD, dt_bias + l * SH, a_log + l * SH, d_skip + l * SH, ssd_norm + l * SW,
                                    CS + ((size_t)((b * ssd::NCH + c) * SH + g * 8)) * 8192, MIX + (size_t)(b * SEQ + c * ssd::LCH) * DM + AW + g * 512, DM, NORM_EPS, tid);
            }
            SEAM(pb + 3);
        }
        if (PH_EN(4) && IN(pb + 4)) {
            PHASE_WS
            pg8::Gemm g{MIX, (const bf16*)(ws + WS_WOUT + l * WOUT_BYTES), MTOK, DM, DM}; pg8::StaticOrder S; S.init(MTOK, DM, G, bx);
            pg8::EpiF32 E{Y, DM};
            pg8::gemm_phase<pg8::EpiF32, pg8::StaticOrder, false, true>(lds, g, S, E, HW_TID());
            SEAM(pb + 4);
        }
        if (PH_EN(5) && IN(pb + 5)) {
            PHASE_LOCALS
            for (int m = gw; m < MTOK; m += NGW) row_update(xres + (size_t)m * DM, Y + (size_t)m * DM, post_mix + l * DM, xres + (size_t)m * DM, XB + (size_t)m * DM, INVB + m, lane);
            SEAM(pb + 5);
        }
        if (PH_EN(6) && IN(pb + 6)) {
            PHASE_WS
            pg8::Gemm g{XB, (const bf16*)(ws + WS_WUP + l * WUP_BYTES), MTOK, DFF, DM}; pg8::StaticOrder S; S.init(MTOK, DFF, G, bx);
            pg8::EpiRowScaleBf16<1> E{HID, DFF, INVB};
            pg8::gemm_phase<pg8::EpiRowScaleBf16<1>, pg8::StaticOrder, true, true>(lds, g, S, E, HW_TID());
            SEAM(pb + 6);
        }
        if (PH_EN(7) && IN(pb + 7)) {
            PHASE_WS
            pg8::Gemm g{HID, (const bf16*)(ws + WS_WDN + l * WDN_BYTES), MTOK, DM, DFF}; pg8::StaticOrder S; S.init(MTOK, DM, G, bx);
            pg8::EpiF32 E{Y, DM};
            pg8::gemm_phase<pg8::EpiF32, pg8::StaticOrder, false, true>(lds, g, S, E, HW_TID());
            SEAM(pb + 7);
        }
        if (PH_EN(8) && IN(pb + 8)) {
            PHASE_LOCALS
            for (int m = gw; m < MTOK; m += NGW) row_update(xres + (size_t)m * DM, Y + (size_t)m * DM, post_mlp + l * DM, xres + (size_t)m * DM, XB + (size_t)m * DM, INVA + m, lane);
            SEAM(pb + 8);
        }
    }
#undef IN
#undef BOTH
#undef SEAM
}

#ifndef N_LAUNCH_MODE
#define N_LAUNCH_MODE 0
#endif
extern "C" void kernel_launch(void* const* d_in, const int* in_sizes, int n_in, void* d_out, int out_size, void* d_ws, size_t ws_size, hipStream_t stream) {
    static int grid = 0;
    if (grid == 0) {
        if (n_in != 17 || out_size != MTOK * DM || ws_size < WS_END) { fprintf(stderr, "kernel_launch: unexpected shapes (n_in %d out %d ws %zu)\n", n_in, out_size, ws_size); grid = -1; return; }
        int dev = 0, cus = 0;
        if (hipGetDevice(&dev) != hipSuccess || hipDeviceGetAttribute(&cus, hipDeviceAttributeMultiprocessorCount, dev) != hipSuccess) { grid = -1; return; }
        if (hipFuncSetAttribute((const void*)fwd_kernel, hipFuncAttributeMaxDynamicSharedMemorySize, LDS_BYTES) != hipSuccess) { fprintf(stderr, "kernel_launch: hipFuncSetAttribute failed\n"); grid = -1; return; }
        (void)hipGetLastError();
        grid = cus;
    }
    if (grid < 0) return;
    (void)hipMemsetAsync((char*)d_ws + WS_CTL, 0, CTL_ZERO_BYTES, stream);
    Args a{};
    for (int i = 0; i < 17; ++i) a.in[i] = d_in[i];
    a.out = (float*)d_out; a.ws = (unsigned char*)d_ws;
#if N_LAUNCH_MODE == 1
    a.ph_lo = 0; a.ph_hi = NPHASES;
    hipLaunchKernelGGL(fwd_kernel, dim3(grid), dim3(NWAVES * 64), LDS_BYTES, stream, a);
#else
    for (int p = 0; p < NPHASES; ++p) { a.ph_lo = p; a.ph_hi = p + 1; hipLaunchKernelGGL(fwd_kernel, dim3(grid), dim3(NWAVES * 64), LDS_BYTES, stream, a); }
#endif
}
```
